# Optimizing an MI355X kernel written in HIP

```python
import math
import jax, jax.numpy as jnp
from jax import lax
import numpy as np

D_MODEL = 1024
BATCH = 8
SEQ = 2048
DEPTH = 1
DEC_BATCH = 128
DEC_SEQ = 1
PAST_LEN = 16384
PAGE_SIZE = 128

N_META = 16
H_A = 8
N_A = 64
W_A = H_A * N_A
D_DECAY = 32
D_AAA = 32
D_GATE = 96
N_A_IN = 3 * W_A + D_DECAY + D_AAA + D_GATE
SPLIT_A = (W_A, 2 * W_A, 3 * W_A, 3 * W_A + D_DECAY, 3 * W_A + D_DECAY + D_AAA)
LNX_EPS = 64e-5
H_B = 4
DK_B = 128
DV_B = 128
W_B = H_B * DV_B
CONV_W = 4
GDN_CHUNK = 64
N_B_IN = 4 * W_B + 2 * H_B
N_IN = N_A_IN + N_B_IN
W_MIX = W_A + W_B
D_FF = 2816
NORM_EPS = 1e-6

kernel_name = "hymba_rwkv7_gdn_macaron_step"


def rms_norm(x, gain):
    xf = x.astype(jnp.float32)
    return xf * lax.rsqrt(jnp.mean(xf * xf, axis=-1, keepdims=True) + NORM_EPS) * gain


def l2norm(x):
    return x * lax.rsqrt(jnp.sum(x * x, axis=-1, keepdims=True) + 1e-12)


def swiglu(x, w_gate, w_up, w_down):
    return (jax.nn.silu(x @ w_gate) * (x @ w_up)) @ w_down


def rwkv7_mixer(pa, shift_prev, s0, mu, w0, w_decay_up, a0, w_a_up, w_g_up, k_k, k_a, r_k, lnx_w, lnx_b):
    B, L, _ = pa.shape
    prev = jnp.concatenate([shift_prev[:, None, :].astype(jnp.float32), pa[:, :-1]], axis=1)
    xm = pa + (prev - pa) * mu
    r, k, v, wd, ad, gd = jnp.split(xm, SPLIT_A, axis=-1)
    w = -jax.nn.softplus(-(w0 + jnp.tanh(wd) @ w_decay_up)) - 0.5
    decay = jnp.exp(-jnp.exp(w))
    a = jax.nn.sigmoid(a0 + ad @ w_a_up)
    g = jax.nn.sigmoid(gd) @ w_g_up
    hd = lambda t: t.reshape(B, L, H_A, N_A)
    kk = l2norm(hd(k * k_k))
    k = k * (1.0 + (a - 1.0) * k_a)
    r_h, k_h, v_h, a_h, w_h = hd(r), hd(k), hd(v), hd(a), hd(decay)
    tm = lambda t: jnp.moveaxis(t, 1, 0)

    def step(S, inp):
        r_t, w_t, k_t, v_t, kk_t, kka_t = inp
        S = (S * w_t[:, :, None, :]
             - jnp.einsum('bhvk,bhk->bhv', S, kk_t)[..., None] * kka_t[:, :, None, :]
             + v_t[..., None] * k_t[:, :, None, :])
        return S, jnp.einsum('bhvk,bhk->bhv', S, r_t)

    s_final, o = lax.scan(step, s0.astype(jnp.float32),
                          (tm(r_h), tm(w_h), tm(k_h), tm(v_h), tm(kk), tm(kk * a_h)))
    o = jnp.moveaxis(o, 0, 1)
    mean = jnp.mean(o, axis=-1, keepdims=True)
    var = jnp.mean(jnp.square(o - mean), axis=-1, keepdims=True)
    o = ((o - mean) * lax.rsqrt(var + LNX_EPS)).reshape(B, L, W_A) * lnx_w + lnx_b
    bonus = jnp.sum(r_h * k_h * r_k, axis=-1, keepdims=True) * v_h
    out = (o + bonus.reshape(B, L, W_A)) * g
    return out, pa[:, -1], s_final


def gdn_chunked(q, k, v, logdecay, beta, s0, chunk):
    B, L, H, _ = q.shape
    n = L // chunk

    def blk(t):
        t = t.reshape((B, n, chunk) + t.shape[2:])
        return jnp.moveaxis(jnp.moveaxis(t, 1, 0), 2, 3)

    qc, kc, vc, gc, bc = blk(q), blk(k), blk(v), blk(logdecay), blk(beta)
    G = jnp.cumsum(gc, axis=-1)
    idx = jnp.arange(chunk)
    causal = idx[:, None] >= idx[None, :]
    strict = idx[:, None] > idx[None, :]
    dmat = jnp.exp(jnp.where(causal, G[..., :, None] - G[..., None, :], -jnp.inf))
    kb = kc * bc[..., None]
    lower = jnp.where(strict, jnp.einsum('nbhid,nbhjd->nbhij', kb, kc) * dmat, 0.0)
    amat = lower + jnp.eye(chunk, dtype=lower.dtype)
    solve = lambda rhs: lax.linalg.triangular_solve(amat, rhs, left_side=True, lower=True,
                                                    unit_diagonal=True)
    u = solve(vc * bc[..., None])
    wk = solve(kb * jnp.exp(G)[..., None])
    qk = jnp.einsum('nbhid,nbhjd->nbhij', qc, kc) * dmat

    def step(S, inp):
        q_i, k_i, u_i, w_i, G_i, qk_i = inp
        v_new = u_i - jnp.einsum('bhcd,bhde->bhce', w_i, S)
        o = (jnp.einsum('bhcd,bhde->bhce', q_i * jnp.exp(G_i)[..., None], S)
             + jnp.einsum('bhij,bhje->bhie', qk_i, v_new))
        g_last = G_i[..., -1:]
        S = (S * jnp.exp(g_last)[..., None]
             + jnp.einsum('bhcd,bhce->bhde', k_i * jnp.exp(g_last - G_i)[..., None], v_new))
        return S, o

    s_final, o = lax.scan(step, s0, (qc, kc, u, wk, G, qk))
    o = jnp.moveaxis(jnp.moveaxis(o, 2, 3), 0, 1).reshape(B, L, H, -1)
    return o, s_final


def gdn_mixer(pb, conv_prev, s0, segments, conv_w, a_log, dt_bias, norm_w):
    B, L, _ = pb.shape
    qkv_raw, z, a_raw, b_raw = jnp.split(pb, (3 * W_B, 4 * W_B, 4 * W_B + H_B), axis=-1)
    full = jnp.concatenate([conv_prev.astype(jnp.float32), qkv_raw], axis=1)
    conv = full[:, 0:L] * conv_w[0]
    for j in range(1, CONV_W):
        conv = conv + full[:, j:j + L] * conv_w[j]
    q, k, v = jnp.split(jax.nn.silu(conv), 3, axis=-1)
    q = l2norm(q.reshape(B, L, H_B, DK_B)) * (DK_B ** -0.5)
    k = l2norm(k.reshape(B, L, H_B, DK_B))
    v = v.reshape(B, L, H_B, DV_B)
    beta = jax.nn.sigmoid(b_raw)
    logdecay = -jnp.exp(a_log) * jax.nn.softplus(a_raw + dt_bias)
    S = s0.astype(jnp.float32)
    outs = []
    start = 0
    for length, chunk in segments:
        seg = slice(start, start + length)
        o_seg, S = gdn_chunked(q[:, seg], k[:, seg], v[:, seg], logdecay[:, seg], beta[:, seg], S, chunk)
        outs.append(o_seg)
        start += length
    o = jnp.concatenate(outs, axis=1)
    o = o * lax.rsqrt(jnp.mean(o * o, axis=-1, keepdims=True) + NORM_EPS) * norm_w
    o = o * jax.nn.silu(z.reshape(B, L, H_B, DV_B))
    return o.reshape(B, L, W_B), full[:, -(CONV_W - 1):], S


def trunk_layer(h, shift_prev, conv_prev, s_rwkv, s_gdn, segments, p):
    h = h + 0.5 * swiglu(rms_norm(h, p['g_ffn1']), p['w_gate1'], p['w_up1'], p['w_down1'])
    proj = rms_norm(h, p['g_mix']) @ p['w_in']
    pa, pb = proj[..., :N_A_IN], proj[..., N_A_IN:]
    o_a, shift_new, rwkv_new = rwkv7_mixer(pa, shift_prev, s_rwkv, p['mu_shift'], p['w0'], p['w_decay_up'],
                                           p['a0'], p['w_a_up'], p['w_g_up'], p['k_k'], p['k_a'],
                                           p['r_k'], p['lnx_w'], p['lnx_b'])
    o_b, conv_new, gdn_new = gdn_mixer(pb, conv_prev, s_gdn, segments, p['conv_w'], p['a_log'],
                                       p['dt_bias'], p['gdn_norm_w'])
    h = h + jnp.concatenate([o_a, o_b], axis=-1) @ p['w_out']
    h = h + 0.5 * swiglu(rms_norm(h, p['g_ffn2']), p['w_gate2'], p['w_up2'], p['w_down2'])
    return h, rwkv_new, shift_new, gdn_new, conv_new


def setup_inputs(seed: int = 0) -> dict:
    key = jax.random.key(seed)
    ks = iter(jax.random.split(key, 48))
    f32 = jnp.float32
    nrm = lambda shape, s: jax.random.normal(next(ks), shape, f32) * s
    uni = lambda shape, lo, hi: jax.random.uniform(next(ks), shape, f32, lo, hi)
    D = D_MODEL
    dt = jnp.exp(uni((DEPTH, H_B), math.log(1e-3), math.log(1e-1)))
    return {
        'x_prompt': nrm((BATCH, SEQ, D), 1.0),
        'x_sample': nrm((DEC_BATCH, DEC_SEQ, D), 1.0),
        'state_rwkv': nrm((DEPTH, DEC_BATCH, H_A, N_A, N_A), 0.3),
        'state_shift': nrm((DEPTH, DEC_BATCH, N_A_IN), 1.0),
        'state_gdn': nrm((DEPTH, DEC_BATCH, H_B, DK_B, DV_B), 0.3),
        'state_conv': nrm((DEPTH, DEC_BATCH, CONV_W - 1, 3 * W_B), 1.0),
        'meta_tokens': nrm((N_META, D), 1.0),
        'g_ffn1': 1.0 + nrm((DEPTH, D), 0.05),
        'w_gate1': nrm((DEPTH, D, D_FF), D ** -0.5),
        'w_up1': nrm((DEPTH, D, D_FF), D ** -0.5),
        'w_down1': nrm((DEPTH, D_FF, D), D_FF ** -0.5),
        'g_mix': 1.0 + nrm((DEPTH, D), 0.05),
        'w_in': nrm((DEPTH, D, N_IN), D ** -0.5),
        'mu_shift': uni((DEPTH, N_A_IN), 0.0, 1.0),
        'w0': uni((DEPTH, W_A), -6.0, -1.0),
        'w_decay_up': nrm((DEPTH, D_DECAY, W_A), 0.1 * D_DECAY ** -0.5),
        'a0': nrm((DEPTH, W_A), 0.1),
        'w_a_up': nrm((DEPTH, D_AAA, W_A), 0.1 * D_AAA ** -0.5),
        'w_g_up': nrm((DEPTH, D_GATE, W_A), D_GATE ** -0.5),
        'k_k': 0.85 + nrm((DEPTH, W_A), 0.05),
        'k_a': 1.0 + nrm((DEPTH, W_A), 0.05),
        'r_k': nrm((DEPTH, H_A, N_A), 0.1),
        'lnx_w': 1.0 + nrm((DEPTH, W_A), 0.05),
        'lnx_b': nrm((DEPTH, W_A), 0.01),
        'conv_w': nrm((DEPTH, CONV_W, 3 * W_B), CONV_W ** -0.5),
        'a_log': jnp.log(uni((DEPTH, H_B), 1.0, 16.0)),
        'dt_bias': dt + jnp.log(-jnp.expm1(-dt)),
        'gdn_norm_w': 1.0 + nrm((DEPTH, DV_B), 0.05),
        'w_out': nrm((DEPTH, W_MIX, D), W_MIX ** -0.5),
        'g_ffn2': 1.0 + nrm((DEPTH, D), 0.05),
        'w_gate2': nrm((DEPTH, D, D_FF), D ** -0.5),
        'w_up2': nrm((DEPTH, D, D_FF), D ** -0.5),
        'w_down2': nrm((DEPTH, D_FF, D), D_FF ** -0.5),
        'g_final': 1.0 + nrm((D,), 0.05),
    }


def reference(x_prompt, x_sample, state_rwkv, state_shift, state_gdn, state_conv, meta_tokens,
              g_ffn1, w_gate1, w_up1, w_down1, g_mix, w_in, mu_shift, w0, w_decay_up, a0, w_a_up,
              w_g_up, k_k, k_a, r_k, lnx_w, lnx_b, conv_w, a_log, dt_bias, gdn_norm_w, w_out,
              g_ffn2, w_gate2, w_up2, w_down2, g_final):
    f32 = jnp.float32
    bp, sp = x_prompt.shape[0], x_prompt.shape[1]
    ss = x_sample.shape[1]
    hp = jnp.concatenate([jnp.broadcast_to(meta_tokens.astype(f32)[None], (bp, N_META, D_MODEL)),
                          x_prompt.astype(f32)], axis=1)
    hs = x_sample.astype(f32)
    prompt_segments = ((N_META, N_META), (sp, GDN_CHUNK))
    sample_segments = ((ss, math.gcd(ss, GDN_CHUNK)),)
    zero_shift = jnp.zeros((bp, N_A_IN), f32)
    zero_conv = jnp.zeros((bp, CONV_W - 1, 3 * W_B), f32)
    zero_rwkv = jnp.zeros((bp, H_A, N_A, N_A), f32)
    zero_gdn = jnp.zeros((bp, H_B, DK_B, DV_B), f32)
    p_rwkv, p_shift, p_gdn, p_conv = [], [], [], []
    s_rwkv, s_shift, s_gdn, s_conv = [], [], [], []
    for l in range(DEPTH):
        lp = dict(g_ffn1=g_ffn1[l], w_gate1=w_gate1[l], w_up1=w_up1[l], w_down1=w_down1[l],
                  g_mix=g_mix[l], w_in=w_in[l], mu_shift=mu_shift[l], w0=w0[l],
                  w_decay_up=w_decay_up[l], a0=a0[l], w_a_up=w_a_up[l], w_g_up=w_g_up[l],
                  k_k=k_k[l], k_a=k_a[l], r_k=r_k[l], lnx_w=lnx_w[l], lnx_b=lnx_b[l],
                  conv_w=conv_w[l], a_log=a_log[l], dt_bias=dt_bias[l], gdn_norm_w=gdn_norm_w[l],
                  w_out=w_out[l], g_ffn2=g_ffn2[l], w_gate2=w_gate2[l], w_up2=w_up2[l],
                  w_down2=w_down2[l])
        hp, r1, sh1, g1, c1 = trunk_layer(hp, zero_shift, zero_conv, zero_rwkv, zero_gdn,
                                          prompt_segments, lp)
        hs, r2, sh2, g2, c2 = trunk_layer(hs, state_shift[l], state_conv[l], state_rwkv[l],
                                          state_gdn[l], sample_segments, lp)
        p_rwkv.append(r1); p_shift.append(sh1); p_gdn.append(g1); p_conv.append(c1)
        s_rwkv.append(r2); s_shift.append(sh2); s_gdn.append(g2); s_conv.append(c2)
    y_prompt = rms_norm(hp, g_final)[:, N_META:].astype(x_prompt.dtype)
    y_sample = rms_norm(hs, g_final).astype(x_sample.dtype)
    return (y_prompt, y_sample,
            jnp.stack(p_rwkv), jnp.stack(p_shift), jnp.stack(p_gdn), jnp.stack(p_conv),
            jnp.stack(s_rwkv), jnp.stack(s_shift), jnp.stack(s_gdn), jnp.stack(s_conv))
```

```cpp
#include <hip/hip_runtime.h>
#include <hip/hip_cooperative_groups.h>
#include <cstdio>
#include <cstdint>
namespace cg = cooperative_groups;
namespace pg8 {
#define PG8_LAS __attribute__((address_space(3)))
typedef unsigned short bf16_t;
typedef short bf16x8 __attribute__((ext_vector_type(8)));
typedef float f32x4 __attribute__((ext_vector_type(4)));
typedef unsigned u32x4 __attribute__((ext_vector_type(4)));
constexpr int BM = 256, BK = 64, HALF = 128, HTB = HALF * BK * 2  , STAGE_BYTES = 8 * HTB, NXCD = 8, WGM = 8;

__host__ __device__ __forceinline__ int lds_byte(int r, int c) { const int st = (r >> 4) * 2 + (c >> 5), rr = r & 15, cc = c & 31, ob = rr * 64 + cc * 2; return st * 1024 + (ob ^ (((ob >> 9) & 1) << 5)); }
__host__ __device__ __forceinline__ void stage_rc(int b, int& R, int& C) { const int st = b / 1024, sb = b % 1024, swz = sb ^ (((sb >> 9) & 1) << 5); R = (st >> 1) * 16 + swz / 64; C = (st & 1) * 32 + (swz % 64) / 2; }
__host__ __device__ __forceinline__ int perm32(int rho) { const int n = rho >> 4, i = rho & 15; return 8 * (i >> 2) + 4 * n + (i & 3); }

struct Unit { int pm, pn; };
struct Gemm { const bf16_t* A; const bf16_t* Bt; int M, N, K; };

struct StaticOrder {
    int nM, nN, nwg, G, c;
    __host__ __device__ void init(int M, int N, int G_, int c_) { nM = M / BM; nN = N / BM; nwg = nM * nN; G = G_; c = c_; }
    __host__ __device__ bool next(int i, Unit& u) const {
        const long L = (long)i * G + c; if (L >= nwg) return false;
        int wgid = (int)L; { const int q = nwg / NXCD, r = nwg % NXCD, xcd = wgid % NXCD, off = wgid / NXCD; wgid = (xcd < r ? xcd * (q + 1) : r * (q + 1) + (xcd - r) * q) + off; }
        const int nig = WGM * nN, gid = wgid / nig, fm = gid * WGM, gsz = (nM - fm) < WGM ? (nM - fm) : WGM;
        u.pm = fm + ((wgid % nig) % gsz); u.pn = (wgid % nig) / gsz; return true;
    }
    __device__ __forceinline__ void a_ready(const Unit&) const {}
    __device__ __forceinline__ void done(const Unit&) const {}
};

__device__ __forceinline__ unsigned cvt_pk_bf16(float lo, float hi) { unsigned r; asm volatile("v_cvt_pk_bf16_f32 %0, %1, %2" : "=v"(r) : "v"(lo), "v"(hi)); return r; }
constexpr int T_ROWS = 16640, NREAL = 16512, NPROMPT = 16384, DM = 1024, DFF = 2816, NINP = 3840;
__device__ __forceinline__ float silu_f(float x) { return x * __builtin_amdgcn_rcpf(1.0f + __builtin_amdgcn_exp2f(-1.44269504f * x)); }
typedef unsigned u32x4e __attribute__((ext_vector_type(4)));

struct EpiSwiglu {
    static constexpr bool PERM = true, AFTER_DRAIN = false;
    bf16_t* O; const float* ssq;
    __device__ __forceinline__ void operator()(const f32x4 (&acc)[2][2][4][2], const Unit& u, int wr, int wc, int fr, int fq) const {
        const int row0 = u.pm * BM + wr * 64 + fr; const int col0 = u.pn * 128 + wc * 32 + 8 * fq;
#pragma unroll
        for (int ai = 0; ai < 2; ++ai)
#pragma unroll
            for (int m = 0; m < 4; ++m) {
                const int row = row0 + ai * HALF + m * 16;
                const float rs = __builtin_amdgcn_rsqf(ssq[row] * (1.0f / 1024.0f) + 1e-6f);
                const f32x4 g0 = acc[ai][0][m][0] * rs, g1 = acc[ai][0][m][1] * rs, u0 = acc[ai][1][m][0] * rs, u1 = acc[ai][1][m][1] * rs;
                u32x4 w;
                w.x = cvt_pk_bf16(silu_f(g0[0]) * u0[0], silu_f(g0[1]) * u0[1]); w.y = cvt_pk_bf16(silu_f(g0[2]) * u0[2], silu_f(g0[3]) * u0[3]);
                w.z = cvt_pk_bf16(silu_f(g1[0]) * u1[0], silu_f(g1[1]) * u1[1]); w.w = cvt_pk_bf16(silu_f(g1[2]) * u1[2], silu_f(g1[3]) * u1[3]);
                *(u32x4*)(O + (size_t)row * DFF + col0) = w;
            }
    }
};
struct EpiProj {
    static constexpr bool PERM = true, AFTER_DRAIN = false;
    bf16_t* O; const float* ssq;
    __device__ __forceinline__ void operator()(const f32x4 (&acc)[2][2][4][2], const Unit& u, int wr, int wc, int fr, int fq) const {
        const int row0 = u.pm * BM + wr * 64 + fr; const int col0 = u.pn * BM + wc * 32 + 8 * fq;
#pragma unroll
        for (int ai = 0; ai < 2; ++ai)
#pragma unroll
            for (int m = 0; m < 4; ++m) {
                const int row = row0 + ai * HALF + m * 16;
                const float rs = __builtin_amdgcn_rsqf(ssq[row] * (1.0f / 1024.0f) + 1e-6f);
#pragma unroll
                for (int bj = 0; bj < 2; ++bj) {
                    const f32x4 v0 = acc[ai][bj][m][0] * rs, v1 = acc[ai][bj][m][1] * rs;
                    u32x4 w; w.x = cvt_pk_bf16(v0[0], v0[1]); w.y = cvt_pk_bf16(v0[2], v0[3]); w.z = cvt_pk_bf16(v1[0], v1[1]); w.w = cvt_pk_bf16(v1[2], v1[3]);
                    *(u32x4*)(O + (size_t)row * NINP + col0 + bj * HALF) = w;
                }
            }
    }
};
__device__ __forceinline__ void bf8_to_f32(const u32x4 w, f32x4& a, f32x4& b) {
    a = (f32x4){__builtin_bit_cast(float, w.x << 16), __builtin_bit_cast(float, w.x & 0xffff0000u), __builtin_bit_cast(float, w.y << 16), __builtin_bit_cast(float, w.y & 0xffff0000u)};
    b = (f32x4){__builtin_bit_cast(float, w.z << 16), __builtin_bit_cast(float, w.z & 0xffff0000u), __builtin_bit_cast(float, w.w << 16), __builtin_bit_cast(float, w.w & 0xffff0000u)};
}
template <int MODE> struct EpiResid {
    static constexpr bool PERM = true, AFTER_DRAIN = false;
    const bf16_t* Hin16; bf16_t* Hb; float* ssq; const float* xp; const float* xs; const float* meta;
    __device__ __forceinline__ void operator()(const f32x4 (&acc)[2][2][4][2], const Unit& u, int wr, int wc, int fr, int fq) const {
        const int row0 = u.pm * BM + wr * 64 + fr; const int col0 = u.pn * BM + wc * 32 + 8 * fq;
        const float SC = (MODE == 1) ? 1.0f : 0.5f;
#pragma unroll
        for (int ai = 0; ai < 2; ++ai) {
            if (MODE != 0 && u.pm * BM + ai * HALF >= NREAL) continue;
            f32x4 hv[4][2][2];
#pragma unroll
            for (int m = 0; m < 4; ++m) {
                const int row = row0 + ai * HALF + m * 16;
#pragma unroll
                for (int bj = 0; bj < 2; ++bj) bf8_to_f32(*(const u32x4*)(Hin16 + (size_t)row * DM + col0 + bj * HALF), hv[m][bj][0], hv[m][bj][1]);
            }
#pragma unroll
            for (int m = 0; m < 4; ++m) {
                const int row = row0 + ai * HALF + m * 16;
                float s = 0.f;
#pragma unroll
                for (int bj = 0; bj < 2; ++bj) {
                    const int c = col0 + bj * HALF;
                    const f32x4 o0 = hv[m][bj][0] + SC * acc[ai][bj][m][0], o1 = hv[m][bj][1] + SC * acc[ai][bj][m][1];
                    u32x4 w; w.x = cvt_pk_bf16(o0[0], o0[1]); w.y = cvt_pk_bf16(o0[2], o0[3]); w.z = cvt_pk_bf16(o1[0], o1[1]); w.w = cvt_pk_bf16(o1[2], o1[3]);
                    *(u32x4*)(Hb + (size_t)row * DM + c) = w;
                    s += (o0[0] * o0[0] + o0[1] * o0[1]) + (o0[2] * o0[2] + o0[3] * o0[3]) + (o1[0] * o1[0] + o1[1] * o1[1]) + (o1[2] * o1[2] + o1[3] * o1[3]);
                }
                s += __shfl_xor(s, 16); s += __shfl_xor(s, 32);
                if (fq == 0) unsafeAtomicAdd(ssq + row, s);
            }
        }
    }
};
struct EpiFinal {
    static constexpr bool PERM = true, AFTER_DRAIN = true;
    const bf16_t* Hin16; float* H; float* ssq; const float* gfin; unsigned* cnt;
    __device__ __forceinline__ void operator()(const f32x4 (&)[2][2][4][2], const Unit&, int, int, int, int) const {}
    __device__ __forceinline__ void fused(const f32x4 (&acc_)[2][2][4][2], const Unit& u, int wr, int wc, int fr, int fq, PG8_LAS unsigned char* lds, int wid, int lane) const {
        f32x4 (&acc)[2][2][4][2] = const_cast<f32x4 (&)[2][2][4][2]>(acc_);
        const int row0 = u.pm * BM + wr * 64 + fr; const int col0 = u.pn * BM + wc * 32 + 8 * fq;
#pragma unroll
        for (int ai = 0; ai < 2; ++ai) {
            f32x4 hv[4][2][2];
#pragma unroll
            for (int m = 0; m < 4; ++m) { const bf16_t* hin = Hin16 + (size_t)(row0 + ai * HALF + m * 16) * DM;
#pragma unroll
                for (int bj = 0; bj < 2; ++bj) bf8_to_f32(*(const u32x4*)(hin + col0 + bj * HALF), hv[m][bj][0], hv[m][bj][1]); }
#pragma unroll
            for (int m = 0; m < 4; ++m) { float s = 0.f;
#pragma unroll
                for (int bj = 0; bj < 2; ++bj) { const f32x4 o0 = hv[m][bj][0] + 0.5f * acc[ai][bj][m][0], o1 = hv[m][bj][1] + 0.5f * acc[ai][bj][m][1];
                    acc[ai][bj][m][0] = o0; acc[ai][bj][m][1] = o1;
                    s += (o0[0] * o0[0] + o0[1] * o0[1]) + (o0[2] * o0[2] + o0[3] * o0[3]) + (o1[0] * o1[0] + o1[1] * o1[1]) + (o1[2] * o1[2] + o1[3] * o1[3]); }
                s += __shfl_xor(s, 16); s += __shfl_xor(s, 32);
                if (fq == 0) unsafeAtomicAdd(ssq + row0 + ai * HALF + m * 16, s); }
        }
        asm volatile("s_waitcnt vmcnt(0)" ::: "memory"); __syncthreads();
        if (threadIdx.x == 0) { unsigned* c = cnt + 64 * u.pm; __hip_atomic_fetch_add(c, 1u, __ATOMIC_RELAXED, __HIP_MEMORY_SCOPE_AGENT);
            unsigned sp = 0; while (__hip_atomic_load(c, __ATOMIC_RELAXED, __HIP_MEMORY_SCOPE_AGENT) < 4u) { __builtin_amdgcn_s_sleep(1); if (++sp > (1u << 22)) break; } }
        __syncthreads();
        f32x4 gv[2][2];
#pragma unroll
        for (int bj = 0; bj < 2; ++bj) { gv[bj][0] = *(const f32x4*)(gfin + col0 + bj * HALF); gv[bj][1] = *(const f32x4*)(gfin + col0 + bj * HALF + 4); }
#pragma unroll
        for (int ai = 0; ai < 2; ++ai)
#pragma unroll
            for (int m = 0; m < 4; ++m) { const int row = row0 + ai * HALF + m * 16;
                const float rs = __builtin_amdgcn_rsqf(__hip_atomic_load(ssq + row, __ATOMIC_RELAXED, __HIP_MEMORY_SCOPE_AGENT) * (1.0f / 1024.0f) + 1e-6f);
#pragma unroll
                for (int bj = 0; bj < 2; ++bj) { float* o = H + (size_t)row * DM + col0 + bj * HALF;
                    __builtin_nontemporal_store(acc[ai][bj][m][0] * rs * gv[bj][0], (f32x4*)o); __builtin_nontemporal_store(acc[ai][bj][m][1] * rs * gv[bj][1], (f32x4*)(o + 4)); } }
    }
};
template <class Epi, class Sched, bool ALIGN_EPI = false, bool SP2 = false>
__device__ __forceinline__ void gemm_phase(PG8_LAS unsigned char* lds, const Gemm g, const Sched& S, const Epi& E) {
    int tid_ = threadIdx.x; asm volatile("" : "+v"(tid_));
    const int tid = tid_, wid = __builtin_amdgcn_readfirstlane(tid >> 6), lane = tid & 63, wr = wid >> 2, wc = wid & 3, fr = lane & 15, fq = lane >> 4;
    const int K = g.K, nt = K / BK;
    unsigned voffA[2], voffB[2];
#pragma unroll
    for (int i = 0; i < 2; ++i) { int R, C; stage_rc(tid * 16 + i * 8192, R, C); const int Rb = Epi::PERM ? ((R & ~31) + perm32(R & 31)) : R;
        voffA[i] = (unsigned)(R * K + C) * 2u; voffB[i] = (unsigned)(Rb * K + C) * 2u; }
    const size_t kstep = (size_t)(BK * 2);
    const size_t hstep = (size_t)HALF * K * 2;
    const size_t tstep = 2 * hstep;
    const unsigned ldsw = (unsigned)wid * 1024u;
    const int aoff = lds_byte(wr * 64 + fr, fq * 8), boff = lds_byte(wc * 32 + fr, fq * 8);
#define PG8_SA(b, h) (((b) * 2 + (h)) * HTB)
#define PG8_SB(b, h) ((4 + (b) * 2 + (h)) * HTB)
#define PG8_STAGE(bufoff, gbase, voff) do { _Pragma("unroll") for (int _i = 0; _i < 2; ++_i) \
        __builtin_amdgcn_global_load_lds((const unsigned*)((const char*)(gbase) + (voff)[_i]), (PG8_LAS unsigned*)(lds + (bufoff) + ldsw + _i * 8192), 16, 0, 0); } while (0)
#define PG8_LDA(dst, b, h) do { _Pragma("unroll") for (int m = 0; m < 4; ++m) _Pragma("unroll") for (int k = 0; k < 2; ++k) dst[m][k] = *(const PG8_LAS bf16x8*)(lds + PG8_SA(b, h) + aoff + m * 2048 + k * 1024); } while (0)
#define PG8_LDB(dst, b, h) do { _Pragma("unroll") for (int n = 0; n < 2; ++n) _Pragma("unroll") for (int k = 0; k < 2; ++k) dst[n][k] = *(const PG8_LAS bf16x8*)(lds + PG8_SB(b, h) + boff + n * 2048 + k * 1024); } while (0)
#define PG8_MMA(ai, bj, At, Bt) do { __builtin_amdgcn_s_setprio(1); _Pragma("unroll") for (int m = 0; m < 4; ++m) _Pragma("unroll") for (int n = 0; n < 2; ++n) _Pragma("unroll") for (int k = 0; k < 2; ++k) \
        acc[ai][bj][m][n] = __builtin_amdgcn_mfma_f32_16x16x32_bf16(Bt[n][k], At[m][k], acc[ai][bj][m][n], 0, 0, 0); __builtin_amdgcn_s_setprio(0); } while (0)
#define PG8_WAIT_V(n) asm volatile("s_waitcnt vmcnt(" #n ")" ::: "memory")
#define PG8_WAIT_L(n) asm volatile("s_waitcnt lgkmcnt(" #n ")" ::: "memory")
#define PG8_BAR __builtin_amdgcn_s_barrier()
#define PG8_SCHED __builtin_amdgcn_sched_barrier(0)
    Unit cur, nxt; int ui = 0;
    if (!S.next(0, cur)) return;
    f32x4 acc[2][2][4][2];
#pragma unroll
    for (int a = 0; a < 2; ++a)
#pragma unroll
        for (int b = 0; b < 2; ++b)
#pragma unroll
            for (int m = 0; m < 4; ++m)
#pragma unroll
                for (int n = 0; n < 2; ++n) acc[a][b][m][n] = (f32x4){0.f, 0.f, 0.f, 0.f};
    bf16x8 At[4][2], B0[2][2], B1[2][2];
    const char* cA = (const char*)g.A + (size_t)cur.pm * tstep; const char* cB = (const char*)g.Bt + (size_t)cur.pn * tstep;
    S.a_ready(cur);
    if constexpr (SP2) {
        PG8_STAGE(PG8_SB(0, 0), cB, voffB); PG8_STAGE(PG8_SB(0, 1), cB + hstep, voffB); PG8_STAGE(PG8_SA(0, 0), cA, voffA); PG8_STAGE(PG8_SA(0, 1), cA + hstep, voffA);
        if (wr == 1) PG8_BAR;
        PG8_WAIT_V(2); PG8_BAR;
        PG8_STAGE(PG8_SB(1, 0), cB + kstep, voffB); PG8_STAGE(PG8_SA(1, 0), cA + kstep, voffA); PG8_STAGE(PG8_SB(1, 1), cB + hstep + kstep, voffB);
        PG8_WAIT_V(6); PG8_BAR;
    } else {
        PG8_STAGE(PG8_SB(0, 0), cB, voffB); PG8_STAGE(PG8_SA(0, 0), cA, voffA); PG8_STAGE(PG8_SB(0, 1), cB + hstep, voffB); PG8_STAGE(PG8_SA(0, 1), cA + hstep, voffA);
        if (wr == 1) PG8_BAR;
        PG8_WAIT_V(4); PG8_BAR;
        PG8_STAGE(PG8_SB(1, 0), cB + kstep, voffB); PG8_STAGE(PG8_SA(1, 0), cA + kstep, voffA); PG8_STAGE(PG8_SB(1, 1), cB + hstep + kstep, voffB);
        PG8_WAIT_V(6); PG8_BAR;
    }
    for (;;) {
        const bool has_next = S.next(ui + 1, nxt);
        const char* nA = has_next ? (const char*)g.A + (size_t)nxt.pm * tstep : cA; const char* nB = has_next ? (const char*)g.Bt + (size_t)nxt.pn * tstep : cB;
        for (int t = 0; t < nt; t += 2) {
            const bool last = (t == nt - 2);
            const char* a1 = cA + (size_t)(t + 1) * kstep;
            const char* a2 = last ? nA : cA + (size_t)(t + 2) * kstep; const char* b2 = last ? nB : cB + (size_t)(t + 2) * kstep;
            const char* a3 = a2 + kstep; const char* b3 = b2 + kstep;
            if (last && has_next) S.a_ready(nxt);
            if constexpr (SP2) {
            PG8_LDB(B0, 0, 0); PG8_LDB(B1, 0, 1); PG8_SCHED; PG8_LDA(At, 0, 0); PG8_STAGE(PG8_SA(1, 1), a1 + hstep, voffA);
            PG8_WAIT_V(8); PG8_WAIT_L(0); PG8_BAR; PG8_MMA(0, 0, At, B0); PG8_MMA(0, 1, At, B1); PG8_BAR; PG8_SCHED;
            PG8_LDA(At, 0, 1); PG8_STAGE(PG8_SB(0, 0), b2, voffB); PG8_STAGE(PG8_SB(0, 1), b2 + hstep, voffB); PG8_STAGE(PG8_SA(0, 0), a2, voffA);
            PG8_WAIT_V(8); PG8_WAIT_L(0); PG8_BAR; PG8_MMA(1, 0, At, B0); PG8_MMA(1, 1, At, B1); PG8_BAR; PG8_SCHED;
            PG8_LDB(B0, 1, 0); PG8_LDB(B1, 1, 1); PG8_SCHED; PG8_LDA(At, 1, 0); PG8_STAGE(PG8_SA(0, 1), a2 + hstep, voffA);
            PG8_WAIT_V(8); PG8_WAIT_L(0); PG8_BAR; PG8_MMA(0, 0, At, B0); PG8_MMA(0, 1, At, B1); PG8_BAR; PG8_SCHED;
            PG8_LDA(At, 1, 1); PG8_STAGE(PG8_SB(1, 0), b3, voffB); PG8_STAGE(PG8_SB(1, 1), b3 + hstep, voffB); PG8_STAGE(PG8_SA(1, 0), a3, voffA);
            PG8_WAIT_V(8); PG8_WAIT_L(0); PG8_BAR; PG8_MMA(1, 0, At, B0); PG8_MMA(1, 1, At, B1); PG8_BAR; PG8_SCHED;
            } else {
            PG8_LDB(B0, 0, 0); PG8_SCHED; PG8_LDA(At, 0, 0); PG8_STAGE(PG8_SA(1, 1), a1 + hstep, voffA);
            PG8_WAIT_L(8); PG8_BAR; PG8_WAIT_L(0); PG8_MMA(0, 0, At, B0); PG8_BAR; PG8_SCHED;
            PG8_LDB(B1, 0, 1); PG8_STAGE(PG8_SB(0, 0), b2, voffB);
            PG8_BAR; PG8_WAIT_L(0); PG8_MMA(0, 1, At, B1); PG8_BAR;
            PG8_LDA(At, 0, 1); PG8_STAGE(PG8_SA(0, 0), a2, voffA);
            PG8_BAR; PG8_WAIT_L(0); PG8_MMA(1, 0, At, B0); PG8_BAR; PG8_SCHED;
            PG8_STAGE(PG8_SB(0, 1), b2 + hstep, voffB);
            PG8_WAIT_V(6); PG8_BAR; PG8_MMA(1, 1, At, B1); PG8_BAR;
            PG8_LDB(B0, 1, 0); PG8_SCHED; PG8_LDA(At, 1, 0); PG8_STAGE(PG8_SA(0, 1), a2 + hstep, voffA);
            PG8_WAIT_L(8); PG8_BAR; PG8_WAIT_L(0); PG8_MMA(0, 0, At, B0); PG8_BAR; PG8_SCHED;
            PG8_LDB(B1, 1, 1); PG8_STAGE(PG8_SB(1, 0), b3, voffB);
            PG8_BAR; PG8_WAIT_L(0); PG8_MMA(0, 1, At, B1); PG8_BAR;
            PG8_LDA(At, 1, 1); PG8_STAGE(PG8_SA(1, 0), a3, voffA);
            PG8_BAR; PG8_WAIT_L(0); PG8_MMA(1, 0, At, B0); PG8_BAR; PG8_SCHED;
            PG8_STAGE(PG8_SB(1, 1), b3 + hstep, voffB);
            PG8_WAIT_V(6); PG8_BAR; PG8_MMA(1, 1, At, B1); PG8_BAR;
            }
        }
        if constexpr (ALIGN_EPI) { if (wr == 0) PG8_BAR; }
        if constexpr (!Epi::AFTER_DRAIN) { E(acc, cur, wr, wc, fr, fq); S.done(cur); }
        if (!has_next) break;
#pragma unroll
        for (int a = 0; a < 2; ++a)
#pragma unroll
            for (int b = 0; b < 2; ++b)
#pragma unroll
                for (int m = 0; m < 4; ++m)
#pragma unroll
                    for (int n = 0; n < 2; ++n) acc[a][b][m][n] = (f32x4){0.f, 0.f, 0.f, 0.f};
        cur = nxt; cA = nA; cB = nB; ++ui;
        if constexpr (ALIGN_EPI) { if (wr == 1) PG8_BAR; }
    }
    PG8_WAIT_V(0);
    if constexpr (!ALIGN_EPI) { if (wr == 0) PG8_BAR; }
    PG8_BAR;
    if constexpr (Epi::AFTER_DRAIN) { E.fused(acc, cur, wr, wc, fr, fq, lds, wid, lane); S.done(cur); }
#undef PG8_SA
#undef PG8_SB
#undef PG8_STAGE
#undef PG8_LDA
#undef PG8_LDB
#undef PG8_MMA
#undef PG8_WAIT_V
#undef PG8_WAIT_L
#undef PG8_BAR
#undef PG8_SCHED
}
}
#define LAS __attribute__((address_space(3)))
typedef unsigned short bf16;
typedef float v4f __attribute__((ext_vector_type(4)));
typedef unsigned v4u __attribute__((ext_vector_type(4)));
typedef unsigned v2u __attribute__((ext_vector_type(2)));
using pg8::T_ROWS; using pg8::NREAL; using pg8::NPROMPT; using pg8::DM; using pg8::DFF; using pg8::NINP;
constexpr int NA_IN = 1696, NB_OFF = 1696, NTHREADS = 512;
constexpr int LDS_BYTES = 147456;
constexpr size_t WS_CTL = 0;
constexpr size_t OFF_BAR = 4 * 16640 * 4, OFF_CNT = OFF_BAR + 16384, CTL_ZERO = OFF_CNT + 80 * 256;
constexpr size_t OFF_TAB = CTL_ZERO, OFF_GB = OFF_TAB + 512, OFF_GE = OFF_GB + 16640 * 16, OFF_BONUS = OFF_GE + 16640 * 16;
constexpr size_t WS_WB = 4u << 20;
constexpr size_t SZ_WGU = (size_t)5632 * 1024 * 2, SZ_WD = (size_t)1024 * 2816 * 2, SZ_WIN = (size_t)3840 * 1024 * 2, SZ_WO = (size_t)1024 * 1024 * 2;
constexpr size_t WS_WGU1 = WS_WB, WS_WD1 = WS_WGU1 + SZ_WGU, WS_WIN = WS_WD1 + SZ_WD, WS_WOUT = WS_WIN + SZ_WIN, WS_WGU2 = WS_WOUT + SZ_WO, WS_WD2 = WS_WGU2 + SZ_WGU;
constexpr size_t WS_HB = WS_WD2 + SZ_WD;
constexpr size_t SZ_ARR = (size_t)16640 * 512 * 2;
constexpr size_t WS_BIG = WS_HB + 2 * SZ_ARR;
constexpr size_t SZ_PROJ = (size_t)16640 * 3840 * 2;
constexpr size_t WS_X3 = WS_BIG + SZ_PROJ, WS_X4 = WS_X3 + SZ_ARR, WS_X5 = WS_X4 + SZ_ARR, WS_END = WS_X5 + SZ_ARR;
static_assert(WS_END <= 268435456, "d_ws map");
static_assert(SZ_WGU + SZ_WD + SZ_WIN >= SZ_ARR, "XA fits in the dead FFN1/Win weights");
constexpr size_t O_YP = 0, O_YS = 16777216, O_RWKV_P = 16908288, O_SHIFT_P = 17170432, O_GDN_P = 17184000, O_CONV_P = 17708288,
                 O_RWKV_S = 17745152, O_SHIFT_S = 21939456, O_GDN_S = 22156544, O_CONV_S = 30545152, O_END = 31134976;

__device__ __forceinline__ float bf2f(unsigned short b) { return __builtin_bit_cast(float, (unsigned)b << 16); }
__device__ __forceinline__ float bflo(unsigned w) { return __builtin_bit_cast(float, w << 16); }
__device__ __forceinline__ float bfhi(unsigned w) { return __builtin_bit_cast(float, w & 0xffff0000u); }
__device__ __forceinline__ unsigned pk2(float lo, float hi) { return pg8::cvt_pk_bf16(lo, hi); }
__device__ __forceinline__ unsigned short f2bf(float f) { return (unsigned short)(pk2(f, 0.f) & 0xffffu); }
template <int CTRL> __device__ __forceinline__ float dpp_f(float x) { return __builtin_bit_cast(float, __builtin_amdgcn_update_dpp(0, __builtin_bit_cast(int, x), CTRL, 0xF, 0xF, true)); }
__device__ __forceinline__ float red16(float x) { x += dpp_f<0xB1>(x); x += dpp_f<0x4E>(x); x += dpp_f<0x141>(x); x += dpp_f<0x140>(x); return x; }
__device__ __forceinline__ float wave_sum(float v) {
    v = red16(v);
    v += __builtin_bit_cast(float, __builtin_amdgcn_update_dpp(0, __builtin_bit_cast(int, v), 0x142, 0xA, 0xF, false));
    v += __builtin_bit_cast(float, __builtin_amdgcn_update_dpp(0, __builtin_bit_cast(int, v), 0x143, 0xC, 0xF, false));
    return __builtin_bit_cast(float, __builtin_amdgcn_readlane(__builtin_bit_cast(int, v), 63));
}
typedef float v2f __attribute__((ext_vector_type(2)));
__device__ __forceinline__ v2f fma2(v2f a, v2f b, v2f c) { return __builtin_elementwise_fma(a, b, c); }
__device__ __forceinline__ float treduce16(const float (&op)[16], int sub, int& j) {
    const bool b3 = sub & 8, b2 = sub & 4, b0 = sub & 1, b1 = sub & 2;
    float a[8], b[4], c[2];
#pragma unroll
    for (int s = 0; s < 8; ++s) { const float keep = b3 ? op[s + 8] : op[s], send = b3 ? op[s] : op[s + 8]; a[s] = keep + dpp_f<0x128>(send); }
#pragma unroll
    for (int s = 0; s < 4; ++s) { const float keep = b2 ? a[s + 4] : a[s], send = b2 ? a[s] : a[s + 4]; b[s] = keep + dpp_f<0x141>(send); }
#pragma unroll
    for (int s = 0; s < 2; ++s) { const float keep = b0 ? b[s + 2] : b[s], send = b0 ? b[s] : b[s + 2]; c[s] = keep + dpp_f<0xB1>(send); }
    const float keep = b1 ? c[1] : c[0], send = b1 ? c[0] : c[1];
    j = (sub & 12) | ((sub & 1) << 1) | ((sub & 2) >> 1);
    return keep + dpp_f<0x4E>(send);
}
__device__ __forceinline__ float sigmoid_f(float x) { return __builtin_amdgcn_rcpf(1.0f + __builtin_amdgcn_exp2f(-1.44269504f * x)); }
__device__ __forceinline__ float softplus_f(float x) { return fmaxf(x, 0.f) + 0.69314718056f * __builtin_amdgcn_logf(1.0f + __builtin_amdgcn_exp2f(-1.44269504f * fabsf(x))); }
__device__ __forceinline__ float exp_f(float x) { return __builtin_amdgcn_exp2f(1.44269504f * x); }
__device__ __forceinline__ float tanh_f(float x) { const float e = __builtin_amdgcn_exp2f(-2.88539008f * fabsf(x)); const float t = (1.0f - e) * __builtin_amdgcn_rcpf(1.0f + e); return x < 0.f ? -t : t; }
__device__ __forceinline__ int seqrow(int b, int pos) { return pos < 16 ? NREAL + b * 16 + pos : b * 2048 + pos - 16; }
#define LDS_WAIT() asm volatile("s_waitcnt lgkmcnt(0)" ::: "memory")
#define XB_TMO      128
#define XB_XCNT(j)  (256  + 64 * (j))
#define XB_XSUB(j)  (1280 + 64 * (j))
#define XB_XGEN(j)  (2304 + 64 * (j))
#define XB_TOP      3328
#define XB_TOPGEN   3392
#define XCD_BAR_WORDS 3456
#define XB_SPIN_CAP (1u << 20)

__device__ __forceinline__ unsigned xb_ld(unsigned* p)              { return __hip_atomic_load(p, __ATOMIC_RELAXED, __HIP_MEMORY_SCOPE_AGENT); }
__device__ __forceinline__ unsigned xb_add(unsigned* p, unsigned v) { return __hip_atomic_fetch_add(p, v, __ATOMIC_RELAXED, __HIP_MEMORY_SCOPE_AGENT); }
__device__ __forceinline__ unsigned xb_xcc_id() { return (unsigned)__builtin_amdgcn_s_getreg((3 << 11) | 20) & 0xFu; }
#define XB_SPIN(cond, bar) do { unsigned _sp = 0; while (cond) { __builtin_amdgcn_s_sleep(1); \
    if ((++_sp & 255u) == 0u) { if (xb_ld(&(bar)[XB_TMO])) break; if (_sp > XB_SPIN_CAP) { atomicAdd(&(bar)[XB_TMO], 1u); break; } } } } while (0)

struct XcdBarrier {
    unsigned* bar; unsigned x;
    volatile LAS unsigned* st;
};

__device__ __forceinline__ XcdBarrier xcd_barrier_post(unsigned* bar, volatile LAS unsigned* st) {
    XcdBarrier b; b.bar = bar; b.x = xb_xcc_id(); b.st = st;
    if (threadIdx.x == 0) (void)xb_add(&bar[XB_XCNT(b.x)], 1u);
    return b;
}
__device__ __forceinline__ void xcd_barrier_complete(unsigned* bar, unsigned x, unsigned& nloc, unsigned& nx) {
    const unsigned G = gridDim.x * gridDim.y * gridDim.z;
    unsigned sum, cnt, mine, sp = 0u;
    for (;;) {
        sum = 0u; cnt = 0u; mine = 0u;
#pragma unroll
        for (unsigned j = 0; j < 16; ++j) { const unsigned c = xb_ld(&bar[XB_XCNT(j)]); sum += c; cnt += (c > 0u) ? 1u : 0u; mine = (j == x) ? c : mine; }
        if (sum == G) break;
        __builtin_amdgcn_s_sleep(1);
        if ((++sp & 255u) == 0u) { if (xb_ld(&bar[XB_TMO])) break; if (sp > XB_SPIN_CAP) { atomicAdd(&bar[XB_TMO], 1u); break; } }
    }
    nloc = mine > 0u ? mine : 1u; nx = cnt > 0u ? cnt : 1u;
}

__device__ __forceinline__ void xcd_barrier(const XcdBarrier& b) {
    asm volatile("s_waitcnt vmcnt(0)" ::: "memory");
    __syncthreads();
    if (threadIdx.x == 0) {
        unsigned* bar = b.bar;
        __builtin_amdgcn_s_waitcnt(0);
        unsigned nloc = b.st[0], nx = b.st[1];
        if (nloc == 0u) { xcd_barrier_complete(bar, b.x, nloc, nx); b.st[0] = nloc; b.st[1] = nx; }
        const unsigned old = xb_add(&bar[XB_XSUB(b.x)], 1u);
        const unsigned gen = old / nloc;
        if (old + 1u == (gen + 1u) * nloc) {
            __builtin_amdgcn_fence(__ATOMIC_RELEASE, "agent");
            asm volatile("s_waitcnt vmcnt(0)" ::: "memory");
            const unsigned og = xb_add(&bar[XB_TOP], 1u);
            const unsigned tg = og / nx;
            if (og + 1u == (tg + 1u) * nx) xb_add(&bar[XB_TOPGEN], 1u);
            else XB_SPIN(xb_ld(&bar[XB_TOPGEN]) == tg, bar);
            __builtin_amdgcn_fence(__ATOMIC_ACQUIRE, "agent");
            xb_add(&bar[XB_XGEN(b.x)], 1u);
            asm volatile("s_waitcnt vmcnt(0)" ::: "memory");
        } else {
            XB_SPIN(xb_ld(&bar[XB_XGEN(b.x)]) == gen, bar);
            __builtin_amdgcn_fence(__ATOMIC_ACQUIRE, "agent");
            asm volatile("s_waitcnt vmcnt(0)" ::: "memory");
        }
    }
    __syncthreads();
}


__device__ __forceinline__ int fresh_tid() { int t = threadIdx.x; asm volatile("" : "+v"(t)); return t; }
struct Args { const float* in[34]; float* out; unsigned char* ws; };
struct Ctx { const float* const* in; float* out; unsigned char* ws; };

struct TrItem { const float* W; const float* gain; bf16* WT; int K, N, mode, k0, n0; };
__device__ __forceinline__ TrItem tr_decode(const Args& a, unsigned char* ws, int r) {
    constexpr int I_G = 16 * 88, I_D = 44 * 32, I_IN = 16 * 120, I_O = 16 * 32;
    TrItem t;
    if (r < I_G) { t = {a.in[8], a.in[7], (bf16*)(ws + WS_WGU1), 1024, 2816, 1, 0, 0}; }
    else if ((r -= I_G) < I_G) { t = {a.in[9], a.in[7], (bf16*)(ws + WS_WGU1), 1024, 2816, 2, 0, 0}; }
    else if ((r -= I_G) < I_D) { t = {a.in[10], nullptr, (bf16*)(ws + WS_WD1), 2816, 1024, 0, 0, 0}; }
    else if ((r -= I_D) < I_IN) { t = {a.in[12], a.in[11], (bf16*)(ws + WS_WIN), 1024, 3752, 3, 0, 0}; }
    else if ((r -= I_IN) < I_O) { t = {a.in[28], nullptr, (bf16*)(ws + WS_WOUT), 1024, 1024, 0, 0, 0}; }
    else if ((r -= I_O) < I_G) { t = {a.in[30], a.in[29], (bf16*)(ws + WS_WGU2), 1024, 2816, 1, 0, 0}; }
    else if ((r -= I_G) < I_G) { t = {a.in[31], a.in[29], (bf16*)(ws + WS_WGU2), 1024, 2816, 2, 0, 0}; }
    else { r -= I_G; t = {a.in[32], nullptr, (bf16*)(ws + WS_WD2), 2816, 1024, 0, 0, 0}; }
    const int nblk = (t.mode == 3) ? 120 : t.N / 32;
    t.k0 = 64 * (r / nblk); t.n0 = 32 * (r % nblk);
    return t;
}
__device__ __forceinline__ void tr_load(const TrItem& t, int lane, v4f (&ld)[8]) {
    const int n4 = t.n0 + 4 * (lane & 7); const bool ok = n4 < t.N;
#pragma unroll
    for (int i = 0; i < 8; ++i) { const int kk = 8 * i + (lane >> 3); ld[i] = ok ? __builtin_nontemporal_load((const v4f*)(t.W + (size_t)(t.k0 + kk) * t.N + n4)) : (v4f){0.f, 0.f, 0.f, 0.f}; }
}
__device__ __forceinline__ void tr_to_lds(const TrItem& t, int lane, const v4f (&ld)[8], LAS float* scr) {
#pragma unroll
    for (int i = 0; i < 8; ++i) { const int kk = 8 * i + (lane >> 3); const float gsc = t.gain ? t.gain[t.k0 + kk] : 1.0f; LAS float* d = scr + kk * 33 + 4 * (lane & 7);
        d[0] = ld[i].x * gsc; d[1] = ld[i].y * gsc; d[2] = ld[i].z * gsc; d[3] = ld[i].w * gsc; }
}
__device__ __forceinline__ void tr_store(const TrItem& t, int lane, LAS float* scr) {
    const int c = lane & 7;
#pragma unroll
    for (int j = 0; j < 4; ++j) { const int nn = (lane >> 3) + 8 * j; const LAS float* s = scr + (8 * c) * 33 + nn;
        v4u o; o.x = pk2(s[0 * 33], s[1 * 33]); o.y = pk2(s[2 * 33], s[3 * 33]); o.z = pk2(s[4 * 33], s[5 * 33]); o.w = pk2(s[6 * 33], s[7 * 33]);
        const int ncol = t.n0 + nn; const int row = (t.mode == 1) ? 256 * (ncol >> 7) + (ncol & 127) : (t.mode == 2) ? 256 * (ncol >> 7) + 128 + (ncol & 127) : ncol;
        *(v4u*)(t.WT + (size_t)row * t.K + t.k0 + 8 * c) = o; }
}
__device__ __forceinline__ void p0_prologue(const Args& a, LAS unsigned char* lds) {
    const int tid = fresh_tid(), lane = tid & 63, wave = tid >> 6;
    LAS float* scr = (LAS float*)(lds + wave * 16384);
    const int gw = blockIdx.x * 8 + wave, NGW = gridDim.x * 8;
    unsigned char* ws = a.ws;
    if (blockIdx.x == 0 && tid == 0) { const float** tab = (const float**)(ws + OFF_TAB);
#pragma unroll
        for (int i = 0; i < 34; ++i) tab[i] = a.in[i]; }
    float* ssq0 = (float*)(ws + WS_CTL);
    bf16* X0b = (bf16*)(ws + WS_HB);
    for (int r = gw; r < T_ROWS; r += 4 * NGW) {
        v4f v[4][4];
#pragma unroll
        for (int u = 0; u < 4; ++u) { const int rr = (r + u * NGW) < T_ROWS ? r + u * NGW : r;
            const float* src = rr < NPROMPT ? a.in[0] + (size_t)rr * DM : (rr < NREAL ? a.in[1] + (size_t)(rr - NPROMPT) * DM : a.in[6] + (size_t)((rr - NREAL) & 15) * DM);
            const v4f* xr = (const v4f*)src + lane;
#pragma unroll
            for (int j = 0; j < 4; ++j) v[u][j] = __builtin_nontemporal_load(xr + 64 * j); }
#pragma unroll
        for (int u = 0; u < 4; ++u) { const int rr = r + u * NGW; if (rr < T_ROWS) {
            float sq = 0.f;
#pragma unroll
            for (int j = 0; j < 4; ++j) sq += (v[u][j].x * v[u][j].x + v[u][j].y * v[u][j].y) + (v[u][j].z * v[u][j].z + v[u][j].w * v[u][j].w);
            sq = wave_sum(sq);
            v2u* o8 = (v2u*)(X0b + (size_t)rr * DM) + lane;
#pragma unroll
            for (int j = 0; j < 4; ++j) { v2u w; w.x = pk2(v[u][j].x, v[u][j].y); w.y = pk2(v[u][j].z, v[u][j].w); o8[64 * j] = w; }
            if (lane == 0) ssq0[rr] = sq; } }
    }
    constexpr int NITEMS = 6 * (16 * 88) + 16 * 120 + 16 * 32;
    v4f ld[8];
    int cur = gw;
    TrItem tc; if (cur < NITEMS) { tc = tr_decode(a, ws, cur); tr_load(tc, lane, ld); }
    while (cur < NITEMS) {
        tr_to_lds(tc, lane, ld, scr);
        const int nxt = cur + NGW; TrItem tn = tc;
        if (nxt < NITEMS) { tn = tr_decode(a, ws, nxt); tr_load(tn, lane, ld); }
        LDS_WAIT(); asm volatile("" ::: "memory");
        tr_store(tc, lane, scr);
        LDS_WAIT(); asm volatile("" ::: "memory");
        tc = tn; cur = nxt;
    }
}

__device__ __forceinline__ float prevval(const bf16* PROJ, const float* sshift, int r, int col) {
    if (r < NPROMPT) { const int s = r & 2047; const int pr = s ? r - 1 : NREAL + (r >> 11) * 16 + 15; return bf2f(PROJ[(size_t)pr * NINP + col]); }
    if (r < NREAL) return sshift[(size_t)(r - NPROMPT) * NA_IN + col];
    return ((r - NREAL) & 15) ? bf2f(PROJ[(size_t)(r - 1) * NINP + col]) : 0.f;
}
__device__ __forceinline__ float tapval(const bf16* PROJ, const float* sconv, int r, int jb, int col) {
    if (r >= NPROMPT && r < NREAL) return sconv[((size_t)(r - NPROMPT) * 3 + (3 - jb)) * 1536 + col];
    int b, pos; if (r < NPROMPT) { b = r >> 11; pos = 16 + (r & 2047); } else { b = (r - NREAL) >> 4; pos = (r - NREAL) & 15; }
    const int pp = pos - jb; if (pp < 0) return 0.f;
    return bf2f(PROJ[(size_t)seqrow(b, pp) * NINP + NB_OFF + col]);
}
struct RowIdx { int t1, t2, t3; float m1, m2, m3; bool samp; };
__device__ __forceinline__ RowIdx rowidx(int r) {
    RowIdx x; int b, pos; x.samp = (r >= NPROMPT) && (r < NREAL);
    if (r < NPROMPT) { b = r >> 11; pos = 16 + (r & 2047); } else if (r >= NREAL) { b = (r - NREAL) >> 4; pos = (r - NREAL) & 15; } else { b = 0; pos = 64; }
    x.t1 = seqrow(b, pos >= 1 ? pos - 1 : 0); x.t2 = seqrow(b, pos >= 2 ? pos - 2 : 0); x.t3 = seqrow(b, pos >= 3 ? pos - 3 : 0);
    x.m1 = pos >= 1 ? 1.f : 0.f; x.m2 = pos >= 2 ? 1.f : 0.f; x.m3 = pos >= 3 ? 1.f : 0.f; return x;
}
__device__ __forceinline__ void p4_prep(const Ctx& a, LAS unsigned char* lds) {
    const int c = fresh_tid(), lane = c & 63, wave = c >> 6;
    unsigned char* ws = a.ws;
    const bf16* PROJ = (const bf16*)(ws + WS_BIG);
    bf16* AD = (bf16*)(ws + WS_WB); bf16* AK = (bf16*)(ws + WS_HB); bf16* AKK = (bf16*)(ws + WS_HB + SZ_ARR); bf16* AKA = (bf16*)(ws + WS_X3);
    bf16* GQ = (bf16*)(ws + WS_X4); bf16* GK = (bf16*)(ws + WS_X5);
    float* GB = (float*)(ws + OFF_GB); float* GE = (float*)(ws + OFF_GE); float* BONUS = (float*)(ws + OFF_BONUS);
    const float* mu = a.in[13]; const float* sshift = a.in[3]; const float* sconv = a.in[5];
    const float mu_r = mu[c], mu_k = mu[512 + c];
    const float w0 = a.in[14][c], a0 = a.in[16][c], kkw = a.in[19][c], kaw = a.in[20][c], rkw = a.in[21][c];
    float wdu[32], wau[32];
#pragma unroll
    for (int j = 0; j < 32; ++j) { wdu[j] = a.in[15][j * 512 + c]; wau[j] = a.in[17][j * 512 + c]; }
    float cq[4], ck[4];
#pragma unroll
    for (int j = 0; j < 4; ++j) { cq[j] = a.in[24][j * 1536 + c]; ck[j] = a.in[24][j * 1536 + 512 + c]; }
    const float mu_x = mu[1536 + (c & 63)];
    const float alog = a.in[25][c & 3], dtb = a.in[26][c & 3];
    LAS float* L = (LAS float*)lds;
    constexpr int RI = 5;
    const int r0 = blockIdx.x * 65;
    for (int it = 0; it < 14; ++it) {
        const bool slow = (it == 13);
        if (slow && blockIdx.x >= 128) break;
        LAS float* Lq = L + (it & 1) * (RI * 96);
        float qv[RI], kv[RI], rr_[RI], kx_[RI], ar_[RI], br_[RI];
        bool st_ok[RI];
#pragma unroll
        for (int j = 0; j < RI; ++j) {
            if (slow && j > 0) break;
            const int r = slow ? NPROMPT + (int)blockIdx.x : r0 + it * RI + j; LAS float* Lp = Lq + j * 96;
            const bf16* pr = PROJ + (size_t)r * NINP;
            float q3, q2, q1, q0, k3, k2, k1, k0, rc, rp, kc_, kp_, xc, xp_;
            q3 = bf2f(pr[NB_OFF + c]); k3 = bf2f(pr[NB_OFF + 512 + c]); rc = bf2f(pr[c]); kc_ = bf2f(pr[512 + c]); xc = bf2f(pr[1536 + (c & 63)]);
            ar_[j] = bf2f(pr[NB_OFF + 2048 + (c & 3)]); br_[j] = bf2f(pr[NB_OFF + 2052 + (c & 3)]);
            if (!slow) {
                const RowIdx X = rowidx(r); st_ok[j] = !X.samp;
                const bf16* p1 = PROJ + (size_t)X.t1 * NINP; const bf16* p2 = PROJ + (size_t)X.t2 * NINP; const bf16* p3 = PROJ + (size_t)X.t3 * NINP;
                q2 = bf2f(p1[NB_OFF + c]) * X.m1; q1 = bf2f(p2[NB_OFF + c]) * X.m2; q0 = bf2f(p3[NB_OFF + c]) * X.m3;
                k2 = bf2f(p1[NB_OFF + 512 + c]) * X.m1; k1 = bf2f(p2[NB_OFF + 512 + c]) * X.m2; k0 = bf2f(p3[NB_OFF + 512 + c]) * X.m3;
                rp = bf2f(p1[c]) * X.m1; kp_ = bf2f(p1[512 + c]) * X.m1; xp_ = bf2f(p1[1536 + (c & 63)]) * X.m1;
            } else {
                st_ok[j] = true; const int i = r - NPROMPT;
                q2 = sconv[((size_t)i * 3 + 2) * 1536 + c]; q1 = sconv[((size_t)i * 3 + 1) * 1536 + c]; q0 = sconv[((size_t)i * 3 + 0) * 1536 + c];
                k2 = sconv[((size_t)i * 3 + 2) * 1536 + 512 + c]; k1 = sconv[((size_t)i * 3 + 1) * 1536 + 512 + c]; k0 = sconv[((size_t)i * 3 + 0) * 1536 + 512 + c];
                rp = sshift[(size_t)i * NA_IN + c]; kp_ = sshift[(size_t)i * NA_IN + 512 + c]; xp_ = sshift[(size_t)i * NA_IN + 1536 + (c & 63)];
            }
            const float qc = (q3 * cq[3] + q2 * cq[2]) + (q1 * cq[1] + q0 * cq[0]), kc = (k3 * ck[3] + k2 * ck[2]) + (k1 * ck[1] + k0 * ck[0]);
            const float q = pg8::silu_f(qc), k = pg8::silu_f(kc); qv[j] = q; kv[j] = k;
            rr_[j] = rc + (rp - rc) * mu_r; kx_[j] = kc_ + (kp_ - kc_) * mu_k;
            const float sq = wave_sum(q * q), sk = wave_sum(k * k);
            if (lane == 0) { Lp[64 + wave] = sq; Lp[72 + wave] = sk; }
            const float xm = xc + (xp_ - xc) * mu_x;
            if (c < 64) Lp[c] = (c < 32) ? tanh_f(xm) : xm;
        }
        __syncthreads();
#pragma unroll
        for (int j = 0; j < RI; ++j) {
            if (slow && j > 0) break;
            const int r = slow ? NPROMPT + (int)blockIdx.x : r0 + it * RI + j; LAS float* Lp = Lq + j * 96;
            const float q = qv[j], k = kv[j];
            const float tq = Lp[64 + wave] + Lp[64 + (wave ^ 1)], tk = Lp[72 + wave] + Lp[72 + (wave ^ 1)];
            float wl = w0, al = a0;
#pragma unroll
            for (int j4 = 0; j4 < 8; ++j4) { const v4f x = *(LAS v4f*)(Lp + 4 * j4), y = *(LAS v4f*)(Lp + 32 + 4 * j4);
#pragma unroll
                for (int i = 0; i < 4; ++i) { wl += x[i] * wdu[4 * j4 + i]; al += y[i] * wau[4 * j4 + i]; } }
            const float wlog = -softplus_f(-wl) - 0.5f; const float e = exp_f(wlog); const float dd = 1.0f - exp_f(-e);
            const float av = sigmoid_f(al);
            const float rr = rr_[j], kx = kx_[j];
            const float kkr = kx * kkw; const float ss = wave_sum(kkr * kkr); const float kkn = kkr * __builtin_amdgcn_rsqf(ss + 1e-12f);
            const float kp = kx * (1.0f + (av - 1.0f) * kaw);
            const float bs = wave_sum(rr * kp * rkw);
            if (st_ok[j]) {
                __builtin_nontemporal_store(f2bf(q * __builtin_amdgcn_rsqf(tq + 1e-12f) * 0.08838834764831845f), GQ + (size_t)r * 512 + c);
                __builtin_nontemporal_store(f2bf(k * __builtin_amdgcn_rsqf(tk + 1e-12f)), GK + (size_t)r * 512 + c);
                if (c < 4) { GB[r * 4 + c] = sigmoid_f(br_[j]); GE[r * 4 + c] = exp_f(-exp_f(alog) * softplus_f(ar_[j] + dtb)); }
                __builtin_nontemporal_store(f2bf(dd), AD + (size_t)r * 512 + c); __builtin_nontemporal_store(f2bf(kp), AK + (size_t)r * 512 + c); __builtin_nontemporal_store(f2bf(kkn), AKK + (size_t)r * 512 + c); __builtin_nontemporal_store(f2bf(kkn * av), AKA + (size_t)r * 512 + c);
                if (lane == 0) BONUS[r * 8 + wave] = bs;
            }
        }
    }
    float* out = a.out;
    const int gt = blockIdx.x * NTHREADS + c, NGT = gridDim.x * NTHREADS;
    for (int i = gt; i < 8 * 1696; i += NGT) { const int b = i / 1696, col = i % 1696; out[O_SHIFT_P + i] = bf2f(PROJ[(size_t)(b * 2048 + 2047) * NINP + col]); }
    for (int i = gt; i < 128 * 1696; i += NGT) { const int b = i / 1696, col = i % 1696; out[O_SHIFT_S + i] = bf2f(PROJ[(size_t)(NPROMPT + b) * NINP + col]); }
    for (int i = gt; i < 8 * 3 * 1536; i += NGT) { const int b = i / 4608, j = (i / 1536) % 3, col = i % 1536; out[O_CONV_P + i] = bf2f(PROJ[(size_t)(b * 2048 + 2045 + j) * NINP + NB_OFF + col]); }
    for (int i = gt; i < 128 * 3 * 1536; i += NGT) { const int b = i / 4608, j = (i / 1536) % 3, col = i % 1536;
        out[O_CONV_S + i] = (j < 2) ? sconv[((size_t)b * 3 + j + 1) * 1536 + col] : bf2f(PROJ[(size_t)(NPROMPT + b) * NINP + NB_OFF + col]); }
}

__device__ __forceinline__ void p6_scan(const Ctx& a, LAS unsigned char* lds) {
    const int tid = fresh_tid(), t2 = tid & 255, half = tid >> 8, tok = t2 >> 4, sub = t2 & 15;
    unsigned char* ws = a.ws;
    bf16* PROJ = (bf16*)(ws + WS_BIG);
    const bf16* AD = (const bf16*)(ws + WS_WB); const bf16* AK = (const bf16*)(ws + WS_HB); const bf16* AKK = (const bf16*)(ws + WS_HB + SZ_ARR); const bf16* AKA = (const bf16*)(ws + WS_X3);
    const bf16* GQ = (const bf16*)(ws + WS_X4); const bf16* GK = (const bf16*)(ws + WS_X5);
    const float* GB = (const float*)(ws + OFF_GB); const float* GE = (const float*)(ws + OFF_GE);
    const float* mu = a.in[13];
    float* out = a.out;
    LAS float* L = (LAS float*)lds;
    constexpr int BUF = 9792, OUTO = 2 * BUF;
    for (int unit = blockIdx.x; unit < 256; unit += gridDim.x) {
        const int xcd_ = unit & 7, slot_ = unit >> 3;
        const int uu = (half == 0) ? ((xcd_ * 8 + (slot_ >> 2)) * 4 + (slot_ & 3)) : ((xcd_ * 4 + (slot_ >> 3)) * 8 + (slot_ & 7));
        int b, h, xb; if (half == 0) { b = uu >> 5; h = (uu >> 2) & 7; xb = uu & 3; } else { b = uu >> 5; h = (uu >> 3) & 3; xb = uu & 7; }
        v4f mu4 = {0.f, 0.f, 0.f, 0.f}; float muv = 0.f; float cw[4] = {0.f, 0.f, 0.f, 0.f};
        int ocol, vcol;
        if (half == 0) { mu4 = *(const v4f*)(mu + h * 64 + 4 * sub); vcol = 1024 + h * 64 + 16 * xb + sub; muv = mu[vcol]; ocol = 512 + h * 64 + 16 * xb + sub; }
        else { vcol = NB_OFF + 1024 + h * 128 + 16 * xb + sub; ocol = NB_OFF + h * 128 + 16 * xb + sub;
#pragma unroll
            for (int j = 0; j < 4; ++j) cw[j] = a.in[24][j * 1536 + 1024 + h * 128 + 16 * xb + sub]; }
        v2f s0 = {0.f, 0.f}, s1 = {0.f, 0.f}, s2 = {0.f, 0.f}, s3 = {0.f, 0.f};
        v2u s_rc, s_rp, s_d, s_k, s_kk, s_ka; v4u s_q, s_gk; unsigned short s_v0 = 0, s_v1 = 0, s_v2 = 0, s_v3 = 0; float s_b = 0.f, s_e = 0.f;
        s_rc = s_rp = s_d = s_k = s_kk = s_ka = (v2u){0u, 0u}; s_q = s_gk = (v4u){0u, 0u, 0u, 0u};
#define P6_LOAD(n) do { const int _n = (n); const int row = (_n == 0) ? NREAL + b * 16 + tok : b * 2048 + (_n - 1) * 16 + tok; \
            if (half == 0) { const int ch = h * 64 + 4 * sub; const int prow = (tok > 0 || _n > 1) ? row - 1 : (_n == 1 ? NREAL + b * 16 + 15 : -1); \
                s_rc = *(const v2u*)(PROJ + (size_t)row * NINP + ch); s_rp = prow >= 0 ? *(const v2u*)(PROJ + (size_t)prow * NINP + ch) : (v2u){0u, 0u}; \
                s_d = *(const v2u*)(AD + (size_t)row * 512 + ch); s_k = *(const v2u*)(AK + (size_t)row * 512 + ch); s_kk = *(const v2u*)(AKK + (size_t)row * 512 + ch); s_ka = *(const v2u*)(AKA + (size_t)row * 512 + ch); \
                s_v0 = PROJ[(size_t)row * NINP + vcol]; s_v1 = prow >= 0 ? PROJ[(size_t)prow * NINP + vcol] : (unsigned short)0; } \
            else { const int ch = h * 128 + 8 * sub; s_q = *(const v4u*)(GQ + (size_t)row * 512 + ch); s_gk = *(const v4u*)(GK + (size_t)row * 512 + ch); \
                const int pos = _n * 16 + tok; s_v0 = PROJ[(size_t)row * NINP + vcol]; \
                s_v1 = pos >= 1 ? PROJ[(size_t)seqrow(b, pos - 1) * NINP + vcol] : (unsigned short)0; s_v2 = pos >= 2 ? PROJ[(size_t)seqrow(b, pos - 2) * NINP + vcol] : (unsigned short)0; \
                s_v3 = pos >= 3 ? PROJ[(size_t)seqrow(b, pos - 3) * NINP + vcol] : (unsigned short)0; \
                if (sub == 0) { s_b = GB[row * 4 + h]; s_e = GE[row * 4 + h]; } } } while (0)
#define P6_WRITE(bufi) do { LAS float* Lb = L + (bufi) * BUF; \
            if (half == 0) { const int o = tok * 64 + 4 * sub; \
                v4f c4 = {bflo(s_rc.x), bfhi(s_rc.x), bflo(s_rc.y), bfhi(s_rc.y)}, p4 = {bflo(s_rp.x), bfhi(s_rp.x), bflo(s_rp.y), bfhi(s_rp.y)}; \
                *(LAS v4f*)(Lb + o) = c4 + (p4 - c4) * mu4; \
                *(LAS v4f*)(Lb + 1024 + o) = (v4f){bflo(s_d.x), bfhi(s_d.x), bflo(s_d.y), bfhi(s_d.y)}; \
                *(LAS v4f*)(Lb + 2048 + o) = (v4f){bflo(s_k.x), bfhi(s_k.x), bflo(s_k.y), bfhi(s_k.y)}; \
                *(LAS v4f*)(Lb + 3072 + o) = (v4f){bflo(s_kk.x), bfhi(s_kk.x), bflo(s_kk.y), bfhi(s_kk.y)}; \
                *(LAS v4f*)(Lb + 4096 + o) = (v4f){bflo(s_ka.x), bfhi(s_ka.x), bflo(s_ka.y), bfhi(s_ka.y)}; \
                const float vc_ = bf2f(s_v0); Lb[5120 + tok * 16 + sub] = vc_ + (bf2f(s_v1) - vc_) * muv; } \
            else { const int o = tok * 128 + 4 * sub;   \
                *(LAS v4f*)(Lb + 5376 + o) = (v4f){bflo(s_q.x), bfhi(s_q.x), bflo(s_q.y), bfhi(s_q.y)}; *(LAS v4f*)(Lb + 5376 + o + 64) = (v4f){bflo(s_q.z), bfhi(s_q.z), bflo(s_q.w), bfhi(s_q.w)}; \
                *(LAS v4f*)(Lb + 7424 + o) = (v4f){bflo(s_gk.x), bfhi(s_gk.x), bflo(s_gk.y), bfhi(s_gk.y)}; *(LAS v4f*)(Lb + 7424 + o + 64) = (v4f){bflo(s_gk.z), bfhi(s_gk.z), bflo(s_gk.w), bfhi(s_gk.w)}; \
                const float cv = bf2f(s_v0) * cw[3] + bf2f(s_v1) * cw[2] + bf2f(s_v2) * cw[1] + bf2f(s_v3) * cw[0]; Lb[9472 + tok * 16 + sub] = pg8::silu_f(cv); \
                if (sub == 0) { Lb[9728 + tok] = s_b; Lb[9744 + tok] = s_e; } } } while (0)
        P6_LOAD(0); P6_WRITE(0);
        __syncthreads();
        for (int n = 0; n < 129; ++n) {
            if (n + 1 < 129) P6_LOAD(n + 1);
            const LAS float* Lb = L + (n & 1) * BUF; LAS float* Lo = L + OUTO + (n & 1) * 512 + half * 256;
            float op[16];
            if (half == 0) {
#pragma unroll
                for (int s = 0; s < 16; ++s) {
                    const LAS float* p = Lb + s * 64 + 4 * sub;
                    const v4f r4 = *(const LAS v4f*)p, d4 = *(const LAS v4f*)(p + 1024), k4 = *(const LAS v4f*)(p + 2048), kk4 = *(const LAS v4f*)(p + 3072), ka4 = *(const LAS v4f*)(p + 4096);
                    const float v = Lb[5120 + s * 16 + tok];
                    v2f t = s0 * kk4.lo; t = fma2(s1, kk4.hi, t);
                    const float sa = red16(t.x + t.y);
                    const v2f vv = {v, v};
                    v2f y0 = fma2(s0, -d4.lo, s0), y1 = fma2(s1, -d4.hi, s1);
                    y0 = fma2(vv, k4.lo, y0); y1 = fma2(vv, k4.hi, y1);
                    const v2f ns = {-sa, -sa};
                    s0 = fma2(ns, ka4.lo, y0); s1 = fma2(ns, ka4.hi, y1);
                    v2f u = s0 * r4.lo; u = fma2(s1, r4.hi, u);
                    op[s] = u.x + u.y;
                }
            } else {
#pragma unroll
                for (int s = 0; s < 16; ++s) {
                    const LAS float* pq = Lb + 5376 + s * 128 + 4 * sub;
                    const v4f q0 = *(const LAS v4f*)pq, q1 = *(const LAS v4f*)(pq + 64), k0 = *(const LAS v4f*)(pq + 2048), k1 = *(const LAS v4f*)(pq + 2048 + 64);
                    const float v = Lb[9472 + s * 16 + tok], be = Lb[9728 + s], eg = Lb[9744 + s];
                    v2f t = s0 * k0.lo; t = fma2(s1, k0.hi, t); v2f u = s2 * k1.lo; u = fma2(s3, k1.hi, u); t += u;
                    const float p = red16(t.x + t.y);
                    const v2f eg2 = {eg, eg};
                    const v2f e0 = s0 * eg2, e1 = s1 * eg2, e2 = s2 * eg2, e3 = s3 * eg2;
                    const float vn = be * (v - eg * p); const v2f vn2 = {vn, vn};
                    s0 = fma2(k0.lo, vn2, e0); s1 = fma2(k0.hi, vn2, e1); s2 = fma2(k1.lo, vn2, e2); s3 = fma2(k1.hi, vn2, e3);
                    v2f w = s0 * q0.lo; w = fma2(s1, q0.hi, w); v2f z = s2 * q1.lo; z = fma2(s3, q1.hi, z); w += z;
                    op[s] = w.x + w.y;
                }
            }
            { int jj; const float tot = treduce16(op, sub, jj); Lo[jj * 16 + tok] = tot; }
            if (n + 1 < 129) P6_WRITE((n + 1) & 1);
            __syncthreads();
            { const int row = (n == 0) ? NREAL + b * 16 + tok : b * 2048 + (n - 1) * 16 + tok; PROJ[(size_t)row * NINP + ocol] = f2bf(Lo[tok * 16 + sub]); }
        }
        if (half == 0) { *(v4f*)(out + O_RWKV_P + ((size_t)((b * 8 + h) * 64 + 16 * xb + tok)) * 64 + 4 * sub) = (v4f){s0.x, s0.y, s1.x, s1.y}; }
        else { const float fs[8] = {s0.x, s0.y, s1.x, s1.y, s2.x, s2.y, s3.x, s3.y};
#pragma unroll
            for (int i = 0; i < 8; ++i) out[O_GDN_P + ((size_t)((b * 4 + h) * 128 + 8 * sub + i)) * 128 + 16 * xb + tok] = fs[i]; }
        __syncthreads();
    }
#undef P6_LOAD
#undef P6_WRITE
    {
        const int g = tid >> 4;
        for (int w = blockIdx.x; w < 2048; w += gridDim.x) {
            const int i = w >> 4, h = (w >> 1) & 7, row = (w & 1) * 32 + g, rt = NPROMPT + i, ch = h * 64 + 4 * sub;
            const v2u rc = *(const v2u*)(PROJ + (size_t)rt * NINP + ch); const v4f rp = *(const v4f*)(a.in[3] + (size_t)i * NA_IN + ch); const v4f m4 = *(const v4f*)(mu + ch);
            const v4f c4 = {bflo(rc.x), bfhi(rc.x), bflo(rc.y), bfhi(rc.y)}; const v4f r4 = c4 + (rp - c4) * m4;
            const v2u ud = *(const v2u*)(AD + (size_t)rt * 512 + ch), uk = *(const v2u*)(AK + (size_t)rt * 512 + ch), ukk = *(const v2u*)(AKK + (size_t)rt * 512 + ch), uka = *(const v2u*)(AKA + (size_t)rt * 512 + ch);
            const v4f d4 = {bflo(ud.x), bfhi(ud.x), bflo(ud.y), bfhi(ud.y)}, k4 = {bflo(uk.x), bfhi(uk.x), bflo(uk.y), bfhi(uk.y)};
            const v4f kk4 = {bflo(ukk.x), bfhi(ukk.x), bflo(ukk.y), bfhi(ukk.y)}, ka4 = {bflo(uka.x), bfhi(uka.x), bflo(uka.y), bfhi(uka.y)};
            const int vc = 1024 + h * 64 + row; const float vcur = bf2f(PROJ[(size_t)rt * NINP + vc]); const float v = vcur + (a.in[3][(size_t)i * NA_IN + vc] - vcur) * mu[vc];
            const size_t so = ((size_t)((i * 8 + h) * 64 + row)) * 64 + 4 * sub;
            v4f s4 = __builtin_nontemporal_load((const v4f*)(a.in[2] + so));
            float sa = (s4[0] * kk4[0] + s4[1] * kk4[1]) + (s4[2] * kk4[2] + s4[3] * kk4[3]); sa = red16(sa);
#pragma unroll
            for (int j = 0; j < 4; ++j) { float x = fmaf(-d4[j], s4[j], s4[j]); x = fmaf(-sa, ka4[j], x); s4[j] = fmaf(v, k4[j], x); }
            float o = (s4[0] * r4[0] + s4[1] * r4[1]) + (s4[2] * r4[2] + s4[3] * r4[3]); o = red16(o);
            __builtin_nontemporal_store(s4, (v4f*)(out + O_RWKV_S + so));
            if (sub == 0) PROJ[(size_t)rt * NINP + 512 + h * 64 + row] = f2bf(o);
        }
    }
    {
        const int e = tid & 127, kq = tid >> 7;
        for (int w = blockIdx.x; w < 512; w += gridDim.x) {
            const int i = w >> 2, h = w & 3, rt = NPROMPT + i;
            __syncthreads();
            if (tid < 128) L[tid] = bf2f(GK[(size_t)rt * 512 + h * 128 + tid]); else if (tid < 256) L[tid] = bf2f(GQ[(size_t)rt * 512 + h * 128 + tid - 128]);
            const int vcq = 1024 + h * 128 + e;
            float cv = bf2f(PROJ[(size_t)rt * NINP + NB_OFF + vcq]) * a.in[24][3 * 1536 + vcq];
#pragma unroll
            for (int j = 0; j < 3; ++j) cv += a.in[5][((size_t)i * 3 + j) * 1536 + vcq] * a.in[24][j * 1536 + vcq];
            const float v = pg8::silu_f(cv), be = GB[rt * 4 + h], eg = GE[rt * 4 + h];
            const size_t so = ((size_t)((i * 4 + h) * 128 + kq * 32)) * 128 + e;
            float S[32];
#pragma unroll
            for (int j = 0; j < 32; ++j) S[j] = __builtin_nontemporal_load(a.in[4] + so + (size_t)j * 128);
            __syncthreads();
            float p = 0.f;
#pragma unroll
            for (int j = 0; j < 32; ++j) p += L[kq * 32 + j] * S[j];
            L[256 + kq * 128 + e] = p;
            __syncthreads();
            p = (L[256 + e] + L[384 + e]) + (L[512 + e] + L[640 + e]);
            const float vn = be * (v - eg * p);
            float o = 0.f;
#pragma unroll
            for (int j = 0; j < 32; ++j) { S[j] = fmaf(L[kq * 32 + j], vn, eg * S[j]); o += L[128 + kq * 32 + j] * S[j]; }
            L[768 + kq * 128 + e] = o;
#pragma unroll
            for (int j = 0; j < 32; ++j) __builtin_nontemporal_store(S[j], out + O_GDN_S + so + (size_t)j * 128);
            __syncthreads();
            if (kq == 0) PROJ[(size_t)rt * NINP + NB_OFF + h * 128 + e] = f2bf((L[768 + e] + L[896 + e]) + (L[1024 + e] + L[1152 + e]));
        }
    }
}

__device__ __forceinline__ void p7_post(const Ctx& a, LAS unsigned char* lds) {
    const int c = fresh_tid(), lane = c & 63, wave = c >> 6;
    unsigned char* ws = a.ws;
    const bf16* PROJ = (const bf16*)(ws + WS_BIG);
    bf16* MIX = (bf16*)(ws + WS_HB);
    const float* BONUS = (const float*)(ws + OFF_BONUS);
    const float* mu = a.in[13]; const float* sshift = a.in[3];
    const int cg_ = c < 96 ? c : 95;
    const float mu_v = mu[1024 + c], lw = a.in[22][c], lb = a.in[23][c], nw = a.in[27][c & 127];
    const float mu_g = mu[1600 + cg_];
    float wg[96];
#pragma unroll
    for (int j = 0; j < 96; ++j) wg[j] = a.in[18][j * 512 + c];
    LAS float* L = (LAS float*)lds;
    constexpr int RI = 5;
    const int r0 = blockIdx.x * 65;
    const int nrows = (NREAL - r0) < 65 ? ((NREAL - r0) < 0 ? 0 : NREAL - r0) : 65;
    const int nit = (nrows + RI - 1) / RI;
    for (int it = 0; it <= nit; ++it) {
        const bool slow = (it == nit);
        if (slow && blockIdx.x >= 128) break;
        LAS float* Lq = L + (it & 1) * (RI * 112);
        float ogv[RI], ov[RI], vv[RI], zv[RI], bv[RI]; bool st_ok[RI];
#pragma unroll
        for (int j = 0; j < RI; ++j) {
            if (slow && j > 0) break;
            int r = r0 + it * RI + j; r = r < r0 + nrows ? r : r0 + nrows - 1; if (slow) r = NPROMPT + (int)blockIdx.x;
            LAS float* Lp = Lq + j * 112;
            const bf16* pr = PROJ + (size_t)r * NINP;
            const float gc = bf2f(pr[1600 + cg_]), vc = bf2f(pr[1024 + c]);
            ogv[j] = bf2f(pr[NB_OFF + c]); ov[j] = bf2f(pr[512 + c]); zv[j] = bf2f(pr[NB_OFF + 1536 + c]); bv[j] = BONUS[r * 8 + wave];
            float gp, vp;
            if (!slow) { const RowIdx X = rowidx(r); st_ok[j] = !X.samp; const bf16* p1 = PROJ + (size_t)X.t1 * NINP; gp = bf2f(p1[1600 + cg_]) * X.m1; vp = bf2f(p1[1024 + c]) * X.m1; }
            else { st_ok[j] = true; const int i = r - NPROMPT; gp = sshift[(size_t)i * NA_IN + 1600 + cg_]; vp = sshift[(size_t)i * NA_IN + 1024 + c]; }
            vv[j] = vc + (vp - vc) * mu_v;
            const float sg = sigmoid_f(gc + (gp - gc) * mu_g);
            if (c < 96) Lp[c] = sg;
            const float s2 = wave_sum(ogv[j] * ogv[j]);
            if (lane == 0) Lp[96 + wave] = s2;
        }
        __syncthreads();
#pragma unroll
        for (int j = 0; j < RI; ++j) {
            if (slow && j > 0) break;
            int r = r0 + it * RI + j; r = r < r0 + nrows ? r : r0 + nrows - 1; if (slow) r = NPROMPT + (int)blockIdx.x;
            LAS float* Lp = Lq + j * 112;
            const float o = ov[j];
            const float mean = wave_sum(o) * (1.0f / 64.0f); const float dlt = o - mean; const float var = wave_sum(dlt * dlt) * (1.0f / 64.0f);
            const float on = dlt * __builtin_amdgcn_rsqf(var + 64e-5f) * lw + lb;
            float g = 0.f;
#pragma unroll
            for (int j4 = 0; j4 < 24; ++j4) { const v4f x = *(LAS v4f*)(Lp + 4 * j4);
#pragma unroll
                for (int i = 0; i < 4; ++i) g += x[i] * wg[4 * j4 + i]; }
            const float ms = (Lp[96 + wave] + Lp[96 + (wave ^ 1)]) * (1.0f / 128.0f);
            if (st_ok[j]) {
                MIX[(size_t)r * DM + c] = f2bf((on + bv[j] * vv[j]) * g);
                MIX[(size_t)r * DM + 512 + c] = f2bf(ogv[j] * __builtin_amdgcn_rsqf(ms + 1e-6f) * nw * pg8::silu_f(zv[j]));
            }
        }
    }
}

__device__ __forceinline__ void p12_final(const Ctx& a) {
    const int tid = fresh_tid(), lane = tid & 63, wave = tid >> 6;
    const int gw = blockIdx.x * 8 + wave, NGW = gridDim.x * 8;
    const float* ssq3 = (const float*)(a.ws + WS_CTL) + 3 * 16640;
    const v4f* gf = (const v4f*)a.in[33] + lane;
    v4f g[4];
#pragma unroll
    for (int j = 0; j < 4; ++j) g[j] = gf[64 * j];
    for (int r = gw; r < NREAL; r += NGW) {
        const float rs = __builtin_amdgcn_rsqf(ssq3[r] * (1.0f / 1024.0f) + 1e-6f);
        v4f* p = (v4f*)(a.out + (size_t)r * DM) + lane;
#pragma unroll
        for (int j = 0; j < 4; ++j) p[64 * j] = p[64 * j] * rs * g[j];
    }
}


template <int MODE> __device__ __forceinline__ void gemm_tail(LAS unsigned char* lds, const bf16* A, const bf16* Bt, int K, float* H, bf16* Hb, float* ssq, const float* xs, const float* meta, const bf16* Hin16 = nullptr, const float* gfin = nullptr, unsigned* cnt = nullptr) {
    const int tid = fresh_tid(), lane = tid & 63, wave = tid >> 6, fr = lane & 15, fq = lane >> 4;
    const int kh = wave >> 2;
    const int nrt = (MODE == 0) ? 16 : 8;
    const float SC = (MODE == 1) ? 1.0f : 0.5f;
    const int ksteps = K / 64;
    LAS v4f* X = (LAS v4f*)lds;
    for (int t = blockIdx.x * 4 + (wave & 3); t < nrt * 64; t += gridDim.x * 4) {
        const int m0 = NPROMPT + (t >> 6) * 16, n0 = (t & 63) * 16;
        const pg8::bf16x8* pa = (const pg8::bf16x8*)(A + (size_t)(m0 + fr) * K + 8 * fq) + 4 * ksteps * kh;
        const pg8::bf16x8* pb = (const pg8::bf16x8*)(Bt + (size_t)(n0 + fr) * K + 8 * fq) + 4 * ksteps * kh;
        v4f acc = {0.f, 0.f, 0.f, 0.f};
        const int row = m0 + fr, col = n0 + 4 * fq;
        v4f hv = {0.f, 0.f, 0.f, 0.f};
        if (kh == 0) { const v2u w = *(const v2u*)(Hin16 + (size_t)row * DM + col); hv = (v4f){bflo(w.x), bfhi(w.x), bflo(w.y), bfhi(w.y)}; }
#pragma unroll 8
        for (int k = 0; k < ksteps; ++k) acc = __builtin_amdgcn_mfma_f32_16x16x32_bf16(pb[4 * k], pa[4 * k], acc, 0, 0, 0);
        if (kh == 1) X[(wave & 3) * 64 + lane] = acc;
        __syncthreads();
        if (MODE == 2) {
            v4f o = {0.f, 0.f, 0.f, 0.f};
            if (kh == 0) { acc += X[(wave & 3) * 64 + lane]; o = hv + SC * acc;
                float sq = (o[0] * o[0] + o[1] * o[1]) + (o[2] * o[2] + o[3] * o[3]);
                sq += __shfl_xor(sq, 16); sq += __shfl_xor(sq, 32);
                if (fq == 0) unsafeAtomicAdd(ssq + row, sq); }
            asm volatile("s_waitcnt vmcnt(0)" ::: "memory"); __syncthreads();
            if (tid == 0) { unsigned* c = cnt + 64 * (64 + (int)((blockIdx.x * 4) >> 6)); __hip_atomic_fetch_add(c, 4u, __ATOMIC_RELAXED, __HIP_MEMORY_SCOPE_AGENT);
                unsigned sp = 0; while (__hip_atomic_load(c, __ATOMIC_RELAXED, __HIP_MEMORY_SCOPE_AGENT) < 64u) { __builtin_amdgcn_s_sleep(1); if (++sp > (1u << 22)) break; } }
            __syncthreads();
            if (kh == 0) { const float rs = __builtin_amdgcn_rsqf(__hip_atomic_load(ssq + row, __ATOMIC_RELAXED, __HIP_MEMORY_SCOPE_AGENT) * (1.0f / 1024.0f) + 1e-6f);
                *(v4f*)(H + (size_t)row * DM + col) = o * rs * *(const v4f*)(gfin + col); }
            continue;
        }
        if (kh == 0) {
            acc += X[(wave & 3) * 64 + lane];
            const v4f o = hv + SC * acc;
            if (MODE != 2) { v2u w; w.x = pk2(o[0], o[1]); w.y = pk2(o[2], o[3]); *(v2u*)(Hb + (size_t)row * DM + col) = w; }
            float sq = (o[0] * o[0] + o[1] * o[1]) + (o[2] * o[2] + o[3] * o[3]);
            sq += __shfl_xor(sq, 16); sq += __shfl_xor(sq, 32);
            if (fq == 0) unsafeAtomicAdd(ssq + row, sq);
        }
        __syncthreads();
    }
}

__global__ void __launch_bounds__(NTHREADS, 2) fwd_kernel(Args a) {
    extern __shared__ __attribute__((aligned(16))) unsigned char lds_raw[];
    LAS unsigned char* lds = (LAS unsigned char*)lds_raw;
    cg::grid_group grid = cg::this_grid();
    unsigned char* ws = a.ws;
    float* ssq = (float*)(ws + WS_CTL);
    const int G = gridDim.x, bx = blockIdx.x;
    if (threadIdx.x < 64) ((LAS unsigned*)(lds + 131072))[threadIdx.x] = 0u;
    __syncthreads();
    XcdBarrier xbar = xcd_barrier_post((unsigned*)(ws + OFF_BAR), (volatile LAS unsigned*)(lds + 131072));
#define GSYNC() xcd_barrier(xbar)

    p0_prologue(a, lds);
    if (a.ws == nullptr) grid.sync();
    GSYNC();
    const Ctx cx{(const float* const*)(ws + OFF_TAB), a.out, a.ws};
    {
        pg8::Gemm g{(const bf16*)(ws + WS_HB), (const bf16*)(ws + WS_WGU1), T_ROWS, 5632, 1024}; pg8::StaticOrder S; S.init(T_ROWS, 5632, G, bx);
        pg8::EpiSwiglu E{(bf16*)(ws + WS_BIG), ssq};
        pg8::gemm_phase<pg8::EpiSwiglu, pg8::StaticOrder, true, true>(lds, g, S, E);
    }
    GSYNC();
    {
        pg8::Gemm g{(const bf16*)(ws + WS_BIG), (const bf16*)(ws + WS_WD1), T_ROWS, 1024, 2816}; pg8::StaticOrder S; S.init(NPROMPT, 1024, G, bx);
        pg8::EpiResid<0> E{(const bf16*)(ws + WS_HB), (bf16*)a.out, ssq + 16640, nullptr, nullptr, nullptr};
        pg8::gemm_phase<pg8::EpiResid<0>, pg8::StaticOrder, true, true>(lds, g, S, E);
        gemm_tail<0>(lds, (const bf16*)(ws + WS_BIG), (const bf16*)(ws + WS_WD1), 2816, nullptr, (bf16*)a.out, ssq + 16640, nullptr, nullptr, (const bf16*)(ws + WS_HB));
    }
    GSYNC();
    {
        pg8::Gemm g{(const bf16*)a.out, (const bf16*)(ws + WS_WIN), T_ROWS, 3840, 1024}; pg8::StaticOrder S; S.init(T_ROWS, 3840, G, bx);
        pg8::EpiProj E{(bf16*)(ws + WS_BIG), ssq + 16640};
        pg8::gemm_phase<pg8::EpiProj, pg8::StaticOrder, true, true>(lds, g, S, E);
    }
    GSYNC();
    p4_prep(cx, lds);
    GSYNC();
    p6_scan(cx, lds);
    GSYNC();
    p7_post(cx, lds);
    GSYNC();
    {
        pg8::Gemm g{(const bf16*)(ws + WS_HB), (const bf16*)(ws + WS_WOUT), T_ROWS, 1024, 1024}; pg8::StaticOrder S; S.init(NPROMPT, 1024, G, bx);
        pg8::EpiResid<1> E{(const bf16*)a.out, (bf16*)(ws + WS_X3), ssq + 2 * 16640, nullptr, nullptr, nullptr};
        pg8::gemm_phase<pg8::EpiResid<1>, pg8::StaticOrder, true, true>(lds, g, S, E);
        gemm_tail<1>(lds, (const bf16*)(ws + WS_HB), (const bf16*)(ws + WS_WOUT), 1024, nullptr, (bf16*)(ws + WS_X3), ssq + 2 * 16640, nullptr, nullptr, (const bf16*)a.out);
    }
    GSYNC();
    {
        pg8::Gemm g{(const bf16*)(ws + WS_X3), (const bf16*)(ws + WS_WGU2), T_ROWS, 5632, 1024}; pg8::StaticOrder S; S.init(T_ROWS, 5632, G, bx);
        pg8::EpiSwiglu E{(bf16*)(ws + WS_BIG), ssq + 2 * 16640};
        pg8::gemm_phase<pg8::EpiSwiglu, pg8::StaticOrder, true, true>(lds, g, S, E);
    }
    GSYNC();
    {
        pg8::Gemm g{(const bf16*)(ws + WS_BIG), (const bf16*)(ws + WS_WD2), T_ROWS, 1024, 2816}; pg8::StaticOrder S; S.init(NPROMPT, 1024, G, bx);
        pg8::EpiFinal E{(const bf16*)(ws + WS_X3), a.out, ssq + 3 * 16640, cx.in[33], (unsigned*)(ws + OFF_CNT)};
        pg8::gemm_phase<pg8::EpiFinal, pg8::StaticOrder, false, true>(lds, g, S, E);
        gemm_tail<2>(lds, (const bf16*)(ws + WS_BIG), (const bf16*)(ws + WS_WD2), 2816, a.out, nullptr, ssq + 3 * 16640, nullptr, nullptr, (const bf16*)(ws + WS_X3), cx.in[33], (unsigned*)(ws + OFF_CNT));
    }
}

extern "C" void kernel_launch(void* const* d_in, const int* in_sizes, int n_in, void* d_out, int out_size, void* d_ws, size_t ws_size, hipStream_t stream) {
    static int grid = 0;
    if (grid == 0) {
        int dev = 0, cus = 0, per_cu = 0;
        hipGetDevice(&dev);
        hipDeviceGetAttribute(&cus, hipDeviceAttributeMultiprocessorCount, dev);
        hipFuncSetAttribute((const void*)fwd_kernel, hipFuncAttributeMaxDynamicSharedMemorySize, LDS_BYTES);
        hipOccupancyMaxActiveBlocksPerMultiprocessor(&per_cu, (const void*)fwd_kernel, NTHREADS, LDS_BYTES);
        if (per_cu < 1) per_cu = 1;
        grid = cus >= 256 ? 256 : cus;
        if (n_in != 34 || ws_size < WS_END || out_size != (int)O_END) { fprintf(stderr, "kernel_launch: unexpected sizes n_in %d ws %zu out %d\n", n_in, ws_size, out_size); }
    }
    hipMemsetAsync((char*)d_ws + WS_CTL, 0, CTL_ZERO, stream);
    Args a{};
    for (int i = 0; i < 34; ++i) a.in[i] = (const float*)d_in[i];
    a.out = (float*)d_out; a.ws = (unsigned char*)d_ws;
    void* args[] = {&a};
    hipError_t e = hipLaunchCooperativeKernel((const void*)fwd_kernel, dim3(grid), dim3(NTHREADS), args, LDS_BYTES, stream);
    if (e != hipSuccess) fprintf(stderr, "cooperative launch failed: %s (grid %d)\n", hipGetErrorString(e), grid);
}
```

```cpp
#include <hip/hip_runtime.h>
#include <hip/hip_cooperative_groups.h>
#include <cstdio>
#include <cstdint>
namespace cg = cooperative_groups;
namespace pg8 {
#define PG8_LAS __attribute__((address_space(3)))
typedef unsigned short bf16_t;
typedef short bf16x8 __attribute__((ext_vector_type(8)));
typedef float f32x4 __attribute__((ext_vector_type(4)));
typedef unsigned u32x4 __attribute__((ext_vector_type(4)));
constexpr int BM = 256, BK = 64, HALF = 128, HTB = HALF * BK * 2  , STAGE_BYTES = 8 * HTB, NXCD = 8, WGM = 8;

__host__ __device__ __forceinline__ int lds_byte(int r, int c) { const int st = (r >> 4) * 2 + (c >> 5), rr = r & 15, cc = c & 31, ob = rr * 64 + cc * 2; return st * 1024 + (ob ^ (((ob >> 9) & 1) << 5)); }
__host__ __device__ __forceinline__ void stage_rc(int b, int& R, int& C) { const int st = b / 1024, sb = b % 1024, swz = sb ^ (((sb >> 9) & 1) << 5); R = (st >> 1) * 16 + swz / 64; C = (st & 1) * 32 + (swz % 64) / 2; }
__host__ __device__ __forceinline__ int perm32(int rho) { const int n = rho >> 4, i = rho & 15; return 8 * (i >> 2) + 4 * n + (i & 3); }

struct Unit { int pm, pn; };
struct Gemm { const bf16_t* A; const bf16_t* Bt; int M, N, K; };

struct StaticOrder {
    int nM, nN, nwg, G, c;
    __host__ __device__ void init(int M, int N, int G_, int c_) { nM = M / BM; nN = N / BM; nwg = nM * nN; G = G_; c = c_; }
    __host__ __device__ bool next(int i, Unit& u) const {
        const long L = (long)i * G + c; if (L >= nwg) return false;
        int wgid = (int)L; { const int q = nwg / NXCD, r = nwg % NXCD, xcd = wgid % NXCD, off = wgid / NXCD; wgid = (xcd < r ? xcd * (q + 1) : r * (q + 1) + (xcd - r) * q) + off; }
        const int nig = WGM * nN, gid = wgid / nig, fm = gid * WGM, gsz = (nM - fm) < WGM ? (nM - fm) : WGM;
        u.pm = fm + ((wgid % nig) % gsz); u.pn = (wgid % nig) / gsz; return true;
    }
    __device__ __forceinline__ void a_ready(const Unit&) const {}
    __device__ __forceinline__ void done(const Unit&) const {}
};

__device__ __forceinline__ unsigned cvt_pk_bf16(float lo, float hi) { unsigned r; asm volatile("v_cvt_pk_bf16_f32 %0, %1, %2" : "=v"(r) : "v"(lo), "v"(hi)); return r; }
constexpr int T_ROWS = 16640, NREAL = 16512, NPROMPT = 16384, DM = 1024, DFF = 2816, NINP = 3840;
__device__ __forceinline__ float silu_f(float x) { return x * __builtin_amdgcn_rcpf(1.0f + __builtin_amdgcn_exp2f(-1.44269504f * x)); }
typedef unsigned u32x4e __attribute__((ext_vector_type(4)));

struct EpiSwiglu {
    static constexpr bool PERM = true, AFTER_DRAIN = false;
    bf16_t* O; const float* ssq;
    __device__ __forceinline__ void operator()(const f32x4 (&acc)[2][2][4][2], const Unit& u, int wr, int wc, int fr, int fq) const {
        const int row0 = u.pm * BM + wr * 64 + fr; const int col0 = u.pn * 128 + wc * 32 + 8 * fq;
#pragma unroll
        for (int ai = 0; ai < 2; ++ai)
#pragma unroll
            for (int m = 0; m < 4; ++m) {
                const int row = row0 + ai * HALF + m * 16;
                const float rs = __builtin_amdgcn_rsqf(ssq[row] * (1.0f / 1024.0f) + 1e-6f);
                const f32x4 g0 = acc[ai][0][m][0] * rs, g1 = acc[ai][0][m][1] * rs, u0 = acc[ai][1][m][0] * rs, u1 = acc[ai][1][m][1] * rs;
                u32x4 w;
                w.x = cvt_pk_bf16(silu_f(g0[0]) * u0[0], silu_f(g0[1]) * u0[1]); w.y = cvt_pk_bf16(silu_f(g0[2]) * u0[2], silu_f(g0[3]) * u0[3]);
                w.z = cvt_pk_bf16(silu_f(g1[0]) * u1[0], silu_f(g1[1]) * u1[1]); w.w = cvt_pk_bf16(silu_f(g1[2]) * u1[2], silu_f(g1[3]) * u1[3]);
                *(u32x4*)(O + (size_t)row * DFF + col0) = w;
            }
    }
};
struct EpiProj {
    static constexpr bool PERM = true, AFTER_DRAIN = false;
    bf16_t* O; const float* ssq;
    __device__ __forceinline__ void operator()(const f32x4 (&acc)[2][2][4][2], const Unit& u, int wr, int wc, int fr, int fq) const {
        const int row0 = u.pm * BM + wr * 64 + fr; const int col0 = u.pn * BM + wc * 32 + 8 * fq;
#pragma unroll
        for (int ai = 0; ai < 2; ++ai)
#pragma unroll
            for (int m = 0; m < 4; ++m) {
                const int row = row0 + ai * HALF + m * 16;
                const float rs = __builtin_amdgcn_rsqf(ssq[row] * (1.0f / 1024.0f) + 1e-6f);
#pragma unroll
                for (int bj = 0; bj < 2; ++bj) {
                    const f32x4 v0 = acc[ai][bj][m][0] * rs, v1 = acc[ai][bj][m][1] * rs;
                    u32x4 w; w.x = cvt_pk_bf16(v0[0], v0[1]); w.y = cvt_pk_bf16(v0[2], v0[3]); w.z = cvt_pk_bf16(v1[0], v1[1]); w.w = cvt_pk_bf16(v1[2], v1[3]);
                    *(u32x4*)(O + (size_t)row * NINP + col0 + bj * HALF) = w;
                }
            }
    }
};
__device__ __forceinline__ void bf8_to_f32(const u32x4 w, f32x4& a, f32x4& b) {
    a = (f32x4){__builtin_bit_cast(float, w.x << 16), __builtin_bit_cast(float, w.x & 0xffff0000u), __builtin_bit_cast(float, w.y << 16), __builtin_bit_cast(float, w.y & 0xffff0000u)};
    b = (f32x4){__builtin_bit_cast(float, w.z << 16), __builtin_bit_cast(float, w.z & 0xffff0000u), __builtin_bit_cast(float, w.w << 16), __builtin_bit_cast(float, w.w & 0xffff0000u)};
}
template <int MODE> struct EpiResid {
    static constexpr bool PERM = true, AFTER_DRAIN = false;
    const bf16_t* Hin16; bf16_t* Hb; float* ssq; const float* xp; const float* xs; const float* meta;
    __device__ __forceinline__ void operator()(const f32x4 (&acc)[2][2][4][2], const Unit& u, int wr, int wc, int fr, int fq) const {
        const int row0 = u.pm * BM + wr * 64 + fr; const int col0 = u.pn * BM + wc * 32 + 8 * fq;
        const float SC = (MODE == 1) ? 1.0f : 0.5f;
#pragma unroll
        for (int ai = 0; ai < 2; ++ai) {
            if (MODE != 0 && u.pm * BM + ai * HALF >= NREAL) continue;
            f32x4 hv[4][2][2];
#pragma unroll
            for (int m = 0; m < 4; ++m) {
                const int row = row0 + ai * HALF + m * 16;
#pragma unroll
                for (int bj = 0; bj < 2; ++bj) bf8_to_f32(*(const u32x4*)(Hin16 + (size_t)row * DM + col0 + bj * HALF), hv[m][bj][0], hv[m][bj][1]);
            }
#pragma unroll
            for (int m = 0; m < 4; ++m) {
                const int row = row0 + ai * HALF + m * 16;
                float s = 0.f;
#pragma unroll
                for (int bj = 0; bj < 2; ++bj) {
                    const int c = col0 + bj * HALF;
                    const f32x4 o0 = hv[m][bj][0] + SC * acc[ai][bj][m][0], o1 = hv[m][bj][1] + SC * acc[ai][bj][m][1];
                    u32x4 w; w.x = cvt_pk_bf16(o0[0], o0[1]); w.y = cvt_pk_bf16(o0[2], o0[3]); w.z = cvt_pk_bf16(o1[0], o1[1]); w.w = cvt_pk_bf16(o1[2], o1[3]);
                    *(u32x4*)(Hb + (size_t)row * DM + c) = w;
                    s += (o0[0] * o0[0] + o0[1] * o0[1]) + (o0[2] * o0[2] + o0[3] * o0[3]) + (o1[0] * o1[0] + o1[1] * o1[1]) + (o1[2] * o1[2] + o1[3] * o1[3]);
                }
                s += __shfl_xor(s, 16); s += __shfl_xor(s, 32);
                if (fq == 0) unsafeAtomicAdd(ssq + row, s);
            }
        }
    }
};
struct EpiFinal {
    static constexpr bool PERM = true, AFTER_DRAIN = true;
    const bf16_t* Hin16; float* H; float* ssq; const float* gfin; unsigned* cnt;
    __device__ __forceinline__ void operator()(const f32x4 (&)[2][2][4][2], const Unit&, int, int, int, int) const {}
    __device__ __forceinline__ void fused(const f32x4 (&acc_)[2][2][4][2], const Unit& u, int wr, int wc, int fr, int fq, PG8_LAS unsigned char* lds, int wid, int lane) const {
        f32x4 (&acc)[2][2][4][2] = const_cast<f32x4 (&)[2][2][4][2]>(acc_);
        const int row0 = u.pm * BM + wr * 64 + fr; const int col0 = u.pn * BM + wc * 32 + 8 * fq;
#pragma unroll
        for (int ai = 0; ai < 2; ++ai) {
            f32x4 hv[4][2][2];
#pragma unroll
            for (int m = 0; m < 4; ++m) { const bf16_t* hin = Hin16 + (size_t)(row0 + ai * HALF + m * 16) * DM;
#pragma unroll
                for (int bj = 0; bj < 2; ++bj) bf8_to_f32(*(const u32x4*)(hin + col0 + bj * HALF), hv[m][bj][0], hv[m][bj][1]); }
#pragma unroll
            for (int m = 0; m < 4; ++m) { float s = 0.f;
#pragma unroll
                for (int bj = 0; bj < 2; ++bj) { const f32x4 o0 = hv[m][bj][0] + 0.5f * acc[ai][bj][m][0], o1 = hv[m][bj][1] + 0.5f * acc[ai][bj][m][1];
                    acc[ai][bj][m][0] = o0; acc[ai][bj][m][1] = o1;
                    s += (o0[0] * o0[0] + o0[1] * o0[1]) + (o0[2] * o0[2] + o0[3] * o0[3]) + (o1[0] * o1[0] + o1[1] * o1[1]) + (o1[2] * o1[2] + o1[3] * o1[3]); }
                s += __shfl_xor(s, 16); s += __shfl_xor(s, 32);
                if (fq == 0) unsafeAtomicAdd(ssq + row0 + ai * HALF + m * 16, s); }
        }
        asm volatile("s_waitcnt vmcnt(0)" ::: "memory"); __syncthreads();
        if (threadIdx.x == 0) { unsigned* c = cnt + 64 * u.pm; __hip_atomic_fetch_add(c, 1u, __ATOMIC_RELAXED, __HIP_MEMORY_SCOPE_AGENT);
            unsigned sp = 0; while (__hip_atomic_load(c, __ATOMIC_RELAXED, __HIP_MEMORY_SCOPE_AGENT) < 4u) { __builtin_amdgcn_s_sleep(1); if (++sp > (1u << 22)) break; } }
        __syncthreads();
        f32x4 gv[2][2];
#pragma unroll
        for (int bj = 0; bj < 2; ++bj) { gv[bj][0] = *(const f32x4*)(gfin + col0 + bj * HALF); gv[bj][1] = *(const f32x4*)(gfin + col0 + bj * HALF + 4); }
#pragma unroll
        for (int ai = 0; ai < 2; ++ai)
#pragma unroll
            for (int m = 0; m < 4; ++m) { const int row = row0 + ai * HALF + m * 16;
                const float rs = __builtin_amdgcn_rsqf(__hip_atomic_load(ssq + row, __ATOMIC_RELAXED, __HIP_MEMORY_SCOPE_AGENT) * (1.0f / 1024.0f) + 1e-6f);
#pragma unroll
                for (int bj = 0; bj < 2; ++bj) { float* o = H + (size_t)row * DM + col0 + bj * HALF;
                    __builtin_nontemporal_store(acc[ai][bj][m][0] * rs * gv[bj][0], (f32x4*)o); __builtin_nontemporal_store(acc[ai][bj][m][1] * rs * gv[bj][1], (f32x4*)(o + 4)); } }
    }
};
template <class Epi, class Sched, bool ALIGN_EPI = false, bool SP2 = false>
__device__ __forceinline__ void gemm_phase(PG8_LAS unsigned char* lds, const Gemm g, const Sched& S, const Epi& E) {
    int tid_ = threadIdx.x; asm volatile("" : "+v"(tid_));
    const int tid = tid_, wid = __builtin_amdgcn_readfirstlane(tid >> 6), lane = tid & 63, wr = wid >> 2, wc = wid & 3, fr = lane & 15, fq = lane >> 4;
    const int K = g.K, nt = K / BK;
    unsigned voffA[2], voffB[2];
#pragma unroll
    for (int i = 0; i < 2; ++i) { int R, C; stage_rc(tid * 16 + i * 8192, R, C); const int Rb = Epi::PERM ? ((R & ~31) + perm32(R & 31)) : R;
        voffA[i] = (unsigned)(R * K + C) * 2u; voffB[i] = (unsigned)(Rb * K + C) * 2u; }
    const size_t kstep = (size_t)(BK * 2);
    const size_t hstep = (size_t)HALF * K * 2;
    const size_t tstep = 2 * hstep;
    const unsigned ldsw = (unsigned)wid * 1024u;
    const int aoff = lds_byte(wr * 64 + fr, fq * 8), boff = lds_byte(wc * 32 + fr, fq * 8);
#define PG8_SA(b, h) (((b) * 2 + (h)) * HTB)
#define PG8_SB(b, h) ((4 + (b) * 2 + (h)) * HTB)
#define PG8_STAGE(bufoff, gbase, voff) do { _Pragma("unroll") for (int _i = 0; _i < 2; ++_i) \
        __builtin_amdgcn_global_load_lds((const unsigned*)((const char*)(gbase) + (voff)[_i]), (PG8_LAS unsigned*)(lds + (bufoff) + ldsw + _i * 8192), 16, 0, 0); } while (0)
#define PG8_LDA(dst, b, h) do { _Pragma("unroll") for (int m = 0; m < 4; ++m) _Pragma("unroll") for (int k = 0; k < 2; ++k) dst[m][k] = *(const PG8_LAS bf16x8*)(lds + PG8_SA(b, h) + aoff + m * 2048 + k * 1024); } while (0)
#define PG8_LDB(dst, b, h) do { _Pragma("unroll") for (int n = 0; n < 2; ++n) _Pragma("unroll") for (int k = 0; k < 2; ++k) dst[n][k] = *(const PG8_LAS bf16x8*)(lds + PG8_SB(b, h) + boff + n * 2048 + k * 1024); } while (0)
#define PG8_MMA(ai, bj, At, Bt) do { __builtin_amdgcn_s_setprio(1); _Pragma("unroll") for (int m = 0; m < 4; ++m) _Pragma("unroll") for (int n = 0; n < 2; ++n) _Pragma("unroll") for (int k = 0; k < 2; ++k) \
        acc[ai][bj][m][n] = __builtin_amdgcn_mfma_f32_16x16x32_bf16(Bt[n][k], At[m][k], acc[ai][bj][m][n], 0, 0, 0); __builtin_amdgcn_s_setprio(0); } while (0)
#define PG8_WAIT_V(n) asm volatile("s_waitcnt vmcnt(" #n ")" ::: "memory")
#define PG8_WAIT_L(n) asm volatile("s_waitcnt lgkmcnt(" #n ")" ::: "memory")
#define PG8_BAR __builtin_amdgcn_s_barrier()
#define PG8_SCHED __builtin_amdgcn_sched_barrier(0)
    Unit cur, nxt; int ui = 0;
    if (!S.next(0, cur)) return;
    f32x4 acc[2][2][4][2];
#pragma unroll
    for (int a = 0; a < 2; ++a)
#pragma unroll
        for (int b = 0; b < 2; ++b)
#pragma unroll
            for (int m = 0; m < 4; ++m)
#pragma unroll
                for (int n = 0; n < 2; ++n) acc[a][b][m][n] = (f32x4){0.f, 0.f, 0.f, 0.f};
    bf16x8 At[4][2], B0[2][2], B1[2][2];
    const char* cA = (const char*)g.A + (size_t)cur.pm * tstep; const char* cB = (const char*)g.Bt + (size_t)cur.pn * tstep;
    S.a_ready(cur);
    if constexpr (SP2) {
        PG8_STAGE(PG8_SB(0, 0), cB, voffB); PG8_STAGE(PG8_SB(0, 1), cB + hstep, voffB); PG8_STAGE(PG8_SA(0, 0), cA, voffA); PG8_STAGE(PG8_SA(0, 1), cA + hstep, voffA);
        if (wr == 1) PG8_BAR;
        PG8_WAIT_V(2); PG8_BAR;
        PG8_STAGE(PG8_SB(1, 0), cB + kstep, voffB); PG8_STAGE(PG8_SA(1, 0), cA + kstep, voffA); PG8_STAGE(PG8_SB(1, 1), cB + hstep + kstep, voffB);
        PG8_WAIT_V(6); PG8_BAR;
    } else {
        PG8_STAGE(PG8_SB(0, 0), cB, voffB); PG8_STAGE(PG8_SA(0, 0), cA, voffA); PG8_STAGE(PG8_SB(0, 1), cB + hstep, voffB); PG8_STAGE(PG8_SA(0, 1), cA + hstep, voffA);
        if (wr == 1) PG8_BAR;
        PG8_WAIT_V(4); PG8_BAR;
        PG8_STAGE(PG8_SB(1, 0), cB + kstep, voffB); PG8_STAGE(PG8_SA(1, 0), cA + kstep, voffA); PG8_STAGE(PG8_SB(1, 1), cB + hstep + kstep, voffB);
        PG8_WAIT_V(6); PG8_BAR;
    }
    for (;;) {
        const bool has_next = S.next(ui + 1, nxt);
        const char* nA = has_next ? (const char*)g.A + (size_t)nxt.pm * tstep : cA; const char* nB = has_next ? (const char*)g.Bt + (size_t)nxt.pn * tstep : cB;
        for (int t = 0; t < nt; t += 2) {
            const bool last = (t == nt - 2);
            const char* a1 = cA + (size_t)(t + 1) * kstep;
            const char* a2 = last ? nA : cA + (size_t)(t + 2) * kstep; const char* b2 = last ? nB : cB + (size_t)(t + 2) * kstep;
            const char* a3 = a2 + kstep; const char* b3 = b2 + kstep;
            if (last && has_next) S.a_ready(nxt);
            if constexpr (SP2) {
            PG8_LDB(B0, 0, 0); PG8_LDB(B1, 0, 1); PG8_SCHED; PG8_LDA(At, 0, 0); PG8_STAGE(PG8_SA(1, 1), a1 + hstep, voffA);
            PG8_WAIT_V(8); PG8_WAIT_L(0); PG8_BAR; PG8_MMA(0, 0, At, B0); PG8_MMA(0, 1, At, B1); PG8_BAR; PG8_SCHED;
            PG8_LDA(At, 0, 1); PG8_STAGE(PG8_SB(0, 0), b2, voffB); PG8_STAGE(PG8_SB(0, 1), b2 + hstep, voffB); PG8_STAGE(PG8_SA(0, 0), a2, voffA);
            PG8_WAIT_V(8); PG8_WAIT_L(0); PG8_BAR; PG8_MMA(1, 0, At, B0); PG8_MMA(1, 1, At, B1); PG8_BAR; PG8_SCHED;
            PG8_LDB(B0, 1, 0); PG8_LDB(B1, 1, 1); PG8_SCHED; PG8_LDA(At, 1, 0); PG8_STAGE(PG8_SA(0, 1), a2 + hstep, voffA);
            PG8_WAIT_V(8); PG8_WAIT_L(0); PG8_BAR; PG8_MMA(0, 0, At, B0); PG8_MMA(0, 1, At, B1); PG8_BAR; PG8_SCHED;
            PG8_LDA(At, 1, 1); PG8_STAGE(PG8_SB(1, 0), b3, voffB); PG8_STAGE(PG8_SB(1, 1), b3 + hstep, voffB); PG8_STAGE(PG8_SA(1, 0), a3, voffA);
            PG8_WAIT_V(8); PG8_WAIT_L(0); PG8_BAR; PG8_MMA(1, 0, At, B0); PG8_MMA(1, 1, At, B1); PG8_BAR; PG8_SCHED;
            } else {
            PG8_LDB(B0, 0, 0); PG8_SCHED; PG8_LDA(At, 0, 0); PG8_STAGE(PG8_SA(1, 1), a1 + hstep, voffA);
            PG8_WAIT_L(8); PG8_BAR; PG8_WAIT_L(0); PG8_MMA(0, 0, At, B0); PG8_BAR; PG8_SCHED;
            PG8_LDB(B1, 0, 1); PG8_STAGE(PG8_SB(0, 0), b2, voffB);
            PG8_BAR; PG8_WAIT_L(0); PG8_MMA(0, 1, At, B1); PG8_BAR;
            PG8_LDA(At, 0, 1); PG8_STAGE(PG8_SA(0, 0), a2, voffA);
            PG8_BAR; PG8_WAIT_L(0); PG8_MMA(1, 0, At, B0); PG8_BAR; PG8_SCHED;
            PG8_STAGE(PG8_SB(0, 1), b2 + hstep, voffB);
            PG8_WAIT_V(6); PG8_BAR; PG8_MMA(1, 1, At, B1); PG8_BAR;
            PG8_LDB(B0, 1, 0); PG8_SCHED; PG8_LDA(At, 1, 0); PG8_STAGE(PG8_SA(0, 1), a2 + hstep, voffA);
            PG8_WAIT_L(8); PG8_BAR; PG8_WAIT_L(0); PG8_MMA(0, 0, At, B0); PG8_BAR; PG8_SCHED;
            PG8_LDB(B1, 1, 1); PG8_STAGE(PG8_SB(1, 0), b3, voffB);
            PG8_BAR; PG8_WAIT_L(0); PG8_MMA(0, 1, At, B1); PG8_BAR;
            PG8_LDA(At, 1, 1); PG8_STAGE(PG8_SA(1, 0), a3, voffA);
            PG8_BAR; PG8_WAIT_L(0); PG8_MMA(1, 0, At, B0); PG8_BAR; PG8_SCHED;
            PG8_STAGE(PG8_SB(1, 1), b3 + hstep, voffB);
            PG8_WAIT_V(6); PG8_BAR; PG8_MMA(1, 1, At, B1); PG8_BAR;
            }
        }
        if constexpr (ALIGN_EPI) { if (wr == 0) PG8_BAR; }
        if constexpr (!Epi::AFTER_DRAIN) { E(acc, cur, wr, wc, fr, fq); S.done(cur); }
        if (!has_next) break;
#pragma unroll
        for (int a = 0; a < 2; ++a)
#pragma unroll
            for (int b = 0; b < 2; ++b)
#pragma unroll
                for (int m = 0; m < 4; ++m)
#pragma unroll
                    for (int n = 0; n < 2; ++n) acc[a][b][m][n] = (f32x4){0.f, 0.f, 0.f, 0.f};
        cur = nxt; cA = nA; cB = nB; ++ui;
        if constexpr (ALIGN_EPI) { if (wr == 1) PG8_BAR; }
    }
    PG8_WAIT_V(0);
    if constexpr (!ALIGN_EPI) { if (wr == 0) PG8_BAR; }
    PG8_BAR;
    if constexpr (Epi::AFTER_DRAIN) { E.fused(acc, cur, wr, wc, fr, fq, lds, wid, lane); S.done(cur); }
#undef PG8_SA
#undef PG8_SB
#undef PG8_STAGE
#undef PG8_LDA
#undef PG8_LDB
#undef PG8_MMA
#undef PG8_WAIT_V
#undef PG8_WAIT_L
#undef PG8_BAR
#undef PG8_SCHED
}
}
#define LAS __attribute__((address_space(3)))
typedef unsigned short bf16;
typedef float v4f __attribute__((ext_vector_type(4)));
typedef unsigned v4u __attribute__((ext_vector_type(4)));
typedef unsigned v2u __attribute__((ext_vector_type(2)));
using pg8::T_ROWS; using pg8::NREAL; using pg8::NPROMPT; using pg8::DM; using pg8::DFF; using pg8::NINP;
constexpr int NA_IN = 1696, NB_OFF = 1696, NTHREADS = 512;
constexpr int LDS_BYTES = 147456;
constexpr size_t WS_CTL = 0;
constexpr size_t OFF_BAR = 4 * 16640 * 4, OFF_CNT = OFF_BAR + 16384, CTL_ZERO = OFF_CNT + 80 * 256;
constexpr size_t OFF_TAB = CTL_ZERO, OFF_GB = OFF_TAB + 512, OFF_GE = OFF_GB + 16640 * 16, OFF_BONUS = OFF_GE + 16640 * 16;
constexpr size_t WS_WB = 4u << 20;
constexpr size_t SZ_WGU = (size_t)5632 * 1024 * 2, SZ_WD = (size_t)1024 * 2816 * 2, SZ_WIN = (size_t)3840 * 1024 * 2, SZ_WO = (size_t)1024 * 1024 * 2;
constexpr size_t WS_WGU1 = WS_WB, WS_WD1 = WS_WGU1 + SZ_WGU, WS_WIN = WS_WD1 + SZ_WD, WS_WOUT = WS_WIN + SZ_WIN, WS_WGU2 = WS_WOUT + SZ_WO, WS_WD2 = WS_WGU2 + SZ_WGU;
constexpr size_t WS_HB = WS_WD2 + SZ_WD;
constexpr size_t SZ_ARR = (size_t)16640 * 512 * 2;
constexpr size_t WS_BIG = WS_HB + 2 * SZ_ARR;
constexpr size_t SZ_PROJ = (size_t)16640 * 3840 * 2;
constexpr size_t WS_X3 = WS_BIG + SZ_PROJ, WS_X4 = WS_X3 + SZ_ARR, WS_X5 = WS_X4 + SZ_ARR, WS_END = WS_X5 + SZ_ARR;
static_assert(WS_END <= 268435456, "d_ws map");
static_assert(SZ_WGU + SZ_WD + SZ_WIN >= SZ_ARR, "XA fits in the dead FFN1/Win weights");
constexpr size_t O_YP = 0, O_YS = 16777216, O_RWKV_P = 16908288, O_SHIFT_P = 17170432, O_GDN_P = 17184000, O_CONV_P = 17708288,
                 O_RWKV_S = 17745152, O_SHIFT_S = 21939456, O_GDN_S = 22156544, O_CONV_S = 30545152, O_END = 31134976;

__device__ __forceinline__ float bf2f(unsigned short b) { return __builtin_bit_cast(float, (unsigned)b << 16); }
__device__ __forceinline__ float bflo(unsigned w) { return __builtin_bit_cast(float, w << 16); }
__device__ __forceinline__ float bfhi(unsigned w) { return __builtin_bit_cast(float, w & 0xffff0000u); }
__device__ __forceinline__ unsigned pk2(float lo, float hi) { return pg8::cvt_pk_bf16(lo, hi); }
__device__ __forceinline__ unsigned short f2bf(float f) { return (unsigned short)(pk2(f, 0.f) & 0xffffu); }
template <int CTRL> __device__ __forceinline__ float dpp_f(float x) { return __builtin_bit_cast(float, __builtin_amdgcn_update_dpp(0, __builtin_bit_cast(int, x), CTRL, 0xF, 0xF, true)); }
__device__ __forceinline__ float red16(float x) { x += dpp_f<0xB1>(x); x += dpp_f<0x4E>(x); x += dpp_f<0x141>(x); x += dpp_f<0x140>(x); return x; }
__device__ __forceinline__ float wave_sum(float v) {
    v = red16(v);
    v += __builtin_bit_cast(float, __builtin_amdgcn_update_dpp(0, __builtin_bit_cast(int, v), 0x142, 0xA, 0xF, false));
    v += __builtin_bit_cast(float, __builtin_amdgcn_update_dpp(0, __builtin_bit_cast(int, v), 0x143, 0xC, 0xF, false));
    return __builtin_bit_cast(float, __builtin_amdgcn_readlane(__builtin_bit_cast(int, v), 63));
}
typedef float v2f __attribute__((ext_vector_type(2)));
__device__ __forceinline__ v2f fma2(v2f a, v2f b, v2f c) { return __builtin_elementwise_fma(a, b, c); }
__device__ __forceinline__ float treduce16(const float (&op)[16], int sub, int& j) {
    const bool b3 = sub & 8, b2 = sub & 4, b0 = sub & 1, b1 = sub & 2;
    float a[8], b[4], c[2];
#pragma unroll
    for (int s = 0; s < 8; ++s) { const float keep = b3 ? op[s + 8] : op[s], send = b3 ? op[s] : op[s + 8]; a[s] = keep + dpp_f<0x128>(send); }
#pragma unroll
    for (int s = 0; s < 4; ++s) { const float keep = b2 ? a[s + 4] : a[s], send = b2 ? a[s] : a[s + 4]; b[s] = keep + dpp_f<0x141>(send); }
#pragma unroll
    for (int s = 0; s < 2; ++s) { const float keep = b0 ? b[s + 2] : b[s], send = b0 ? b[s] : b[s + 2]; c[s] = keep + dpp_f<0xB1>(send); }
    const float keep = b1 ? c[1] : c[0], send = b1 ? c[0] : c[1];
    j = (sub & 12) | ((sub & 1) << 1) | ((sub & 2) >> 1);
    return keep + dpp_f<0x4E>(send);
}
__device__ __forceinline__ float sigmoid_f(float x) { return __builtin_amdgcn_rcpf(1.0f + __builtin_amdgcn_exp2f(-1.44269504f * x)); }
__device__ __forceinline__ float softplus_f(float x) { return fmaxf(x, 0.f) + 0.69314718056f * __builtin_amdgcn_logf(1.0f + __builtin_amdgcn_exp2f(-1.44269504f * fabsf(x))); }
__device__ __forceinline__ float exp_f(float x) { return __builtin_amdgcn_exp2f(1.44269504f * x); }
__device__ __forceinline__ float tanh_f(float x) { const float e = __builtin_amdgcn_exp2f(-2.88539008f * fabsf(x)); const float t = (1.0f - e) * __builtin_amdgcn_rcpf(1.0f + e); return x < 0.f ? -t : t; }
__device__ __forceinline__ int seqrow(int b, int pos) { return pos < 16 ? NREAL + b * 16 + pos : b * 2048 + pos - 16; }
#define LDS_WAIT() asm volatile("s_waitcnt lgkmcnt(0)" ::: "memory")
#define XB_TMO      128
#define XB_XCNT(j)  (256  + 64 * (j))
#define XB_XSUB(j)  (1280 + 64 * (j))
#define XB_XGEN(j)  (2304 + 64 * (j))
#define XB_TOP      3328
#define XB_TOPGEN   3392
#define XCD_BAR_WORDS 3456
#define XB_SPIN_CAP (1u << 20)

__device__ __forceinline__ unsigned xb_ld(unsigned* p)              { return __hip_atomic_load(p, __ATOMIC_RELAXED, __HIP_MEMORY_SCOPE_AGENT); }
__device__ __forceinline__ unsigned xb_add(unsigned* p, unsigned v) { return __hip_atomic_fetch_add(p, v, __ATOMIC_RELAXED, __HIP_MEMORY_SCOPE_AGENT); }
__device__ __forceinline__ unsigned xb_xcc_id() { return (unsigned)__builtin_amdgcn_s_getreg((3 << 11) | 20) & 0xFu; }
#define XB_SPIN(cond, bar) do { unsigned _sp = 0; while (cond) { __builtin_amdgcn_s_sleep(1); \
    if ((++_sp & 255u) == 0u) { if (xb_ld(&(bar)[XB_TMO])) break; if (_sp > XB_SPIN_CAP) { atomicAdd(&(bar)[XB_TMO], 1u); break; } } } } while (0)

struct XcdBarrier {
    unsigned* bar; unsigned x;
    volatile LAS unsigned* st;
};

__device__ __forceinline__ XcdBarrier xcd_barrier_post(unsigned* bar, volatile LAS unsigned* st) {
    XcdBarrier b; b.bar = bar; b.x = xb_xcc_id(); b.st = st;
    if (threadIdx.x == 0) (void)xb_add(&bar[XB_XCNT(b.x)], 1u);
    return b;
}
__device__ __forceinline__ void xcd_barrier_complete(unsigned* bar, unsigned x, unsigned& nloc, unsigned& nx) {
    const unsigned G = gridDim.x * gridDim.y * gridDim.z;
    unsigned sum, cnt, mine, sp = 0u;
    for (;;) {
        sum = 0u; cnt = 0u; mine = 0u;
#pragma unroll
        for (unsigned j = 0; j < 16; ++j) { const unsigned c = xb_ld(&bar[XB_XCNT(j)]); sum += c; cnt += (c > 0u) ? 1u : 0u; mine = (j == x) ? c : mine; }
        if (sum == G) break;
        __builtin_amdgcn_s_sleep(1);
        if ((++sp & 255u) == 0u) { if (xb_ld(&bar[XB_TMO])) break; if (sp > XB_SPIN_CAP) { atomicAdd(&bar[XB_TMO], 1u); break; } }
    }
    nloc = mine > 0u ? mine : 1u; nx = cnt > 0u ? cnt : 1u;
}

__device__ __forceinline__ void xcd_barrier(const XcdBarrier& b) {
    asm volatile("s_waitcnt vmcnt(0)" ::: "memory");
    __syncthreads();
    if (threadIdx.x == 0) {
        unsigned* bar = b.bar;
        __builtin_amdgcn_s_waitcnt(0);
        unsigned nloc = b.st[0], nx = b.st[1];
        if (nloc == 0u) { xcd_barrier_complete(bar, b.x, nloc, nx); b.st[0] = nloc; b.st[1] = nx; }
        const unsigned old = xb_add(&bar[XB_XSUB(b.x)], 1u);
        const unsigned gen = old / nloc;
        if (old + 1u == (gen + 1u) * nloc) {
            __builtin_amdgcn_fence(__ATOMIC_RELEASE, "agent");
            asm volatile("s_waitcnt vmcnt(0)" ::: "memory");
            const unsigned og = xb_add(&bar[XB_TOP], 1u);
            const unsigned tg = og / nx;
            if (og + 1u == (tg + 1u) * nx) xb_add(&bar[XB_TOPGEN], 1u);
            else XB_SPIN(xb_ld(&bar[XB_TOPGEN]) == tg, bar);
            __builtin_amdgcn_fence(__ATOMIC_ACQUIRE, "agent");
            xb_add(&bar[XB_XGEN(b.x)], 1u);
            asm volatile("s_waitcnt vmcnt(0)" ::: "memory");
        } else {
            XB_SPIN(xb_ld(&bar[XB_XGEN(b.x)]) == gen, bar);
            __builtin_amdgcn_fence(__ATOMIC_ACQUIRE, "agent");
            asm volatile("s_waitcnt vmcnt(0)" ::: "memory");
        }
    }
    __syncthreads();
}


__device__ __forceinline__ int fresh_tid() { int t = threadIdx.x; asm volatile("" : "+v"(t)); return t; }
struct Args { const float* in[34]; float* out; unsigned char* ws; };
struct Ctx { const float* const* in; float* out; unsigned char* ws; };

struct TrItem { const float* W; const float* gain; bf16* WT; int K, N, mode, k0, n0, late; };
__device__ __forceinline__ TrItem tr_decode(const Args& a, unsigned char* ws, int r) {
    constexpr int I_G = 16 * 88, I_D = 44 * 32, I_IN = 16 * 120, I_O = 16 * 32;
    TrItem t;
    if (r < I_G) { t = {a.in[8], a.in[7], (bf16*)(ws + WS_WGU1), 1024, 2816, 1, 0, 0, 0}; }
    else if ((r -= I_G) < I_G) { t = {a.in[9], a.in[7], (bf16*)(ws + WS_WGU1), 1024, 2816, 2, 0, 0, 0}; }
    else if ((r -= I_G) < I_D) { t = {a.in[10], nullptr, (bf16*)(ws + WS_WD1), 2816, 1024, 0, 0, 0, 1}; }
    else if ((r -= I_D) < I_IN) { t = {a.in[12], a.in[11], (bf16*)(ws + WS_WIN), 1024, 3752, 3, 0, 0, 1}; }
    else if ((r -= I_IN) < I_O) { t = {a.in[28], nullptr, (bf16*)(ws + WS_WOUT), 1024, 1024, 0, 0, 0, 1}; }
    else if ((r -= I_O) < I_G) { t = {a.in[30], a.in[29], (bf16*)(ws + WS_WGU2), 1024, 2816, 1, 0, 0, 1}; }
    else if ((r -= I_G) < I_G) { t = {a.in[31], a.in[29], (bf16*)(ws + WS_WGU2), 1024, 2816, 2, 0, 0, 1}; }
    else { r -= I_G; t = {a.in[32], nullptr, (bf16*)(ws + WS_WD2), 2816, 1024, 0, 0, 0, 1}; }
    const int nblk = (t.mode == 3) ? 120 : t.N / 32;
    t.k0 = 64 * (r / nblk); t.n0 = 32 * (r % nblk);
    return t;
}
__device__ __forceinline__ void tr_load(const TrItem& t, int lane, v4f (&ld)[8]) {
    const int n4 = t.n0 + 4 * (lane & 7); const bool ok = n4 < t.N;
#pragma unroll
    for (int i = 0; i < 8; ++i) { const int kk = 8 * i + (lane >> 3); ld[i] = ok ? __builtin_nontemporal_load((const v4f*)(t.W + (size_t)(t.k0 + kk) * t.N + n4)) : (v4f){0.f, 0.f, 0.f, 0.f}; }
}
__device__ __forceinline__ void tr_to_lds(const TrItem& t, int lane, const v4f (&ld)[8], LAS float* scr) {
#pragma unroll
    for (int i = 0; i < 8; ++i) { const int kk = 8 * i + (lane >> 3); const float gsc = t.gain ? t.gain[t.k0 + kk] : 1.0f; LAS float* d = scr + kk * 33 + 4 * (lane & 7);
        d[0] = ld[i].x * gsc; d[1] = ld[i].y * gsc; d[2] = ld[i].z * gsc; d[3] = ld[i].w * gsc; }
}
__device__ __forceinline__ void tr_store(const TrItem& t, int lane, LAS float* scr) {
    const int c = lane & 7;
#pragma unroll
    for (int j = 0; j < 4; ++j) { const int nn = (lane >> 3) + 8 * j; const LAS float* s = scr + (8 * c) * 33 + nn;
        v4u o; o.x = pk2(s[0 * 33], s[1 * 33]); o.y = pk2(s[2 * 33], s[3 * 33]); o.z = pk2(s[4 * 33], s[5 * 33]); o.w = pk2(s[6 * 33], s[7 * 33]);
        const int ncol = t.n0 + nn; const int row = (t.mode == 1) ? 256 * (ncol >> 7) + (ncol & 127) : (t.mode == 2) ? 256 * (ncol >> 7) + 128 + (ncol & 127) : ncol;
        v4u* dst = (v4u*)(t.WT + (size_t)row * t.K + t.k0 + 8 * c); if (t.late) __builtin_nontemporal_store(o, dst); else *dst = o; }
}
__device__ __forceinline__ void p0_prologue(const Args& a, LAS unsigned char* lds) {
    const int tid = fresh_tid(), lane = tid & 63, wave = tid >> 6;
    LAS float* scr = (LAS float*)(lds + wave * 16384);
    const int gw = blockIdx.x * 8 + wave, NGW = gridDim.x * 8;
    unsigned char* ws = a.ws;
    if (blockIdx.x == 0 && tid == 0) { const float** tab = (const float**)(ws + OFF_TAB);
#pragma unroll
        for (int i = 0; i < 34; ++i) tab[i] = a.in[i]; }
    float* ssq0 = (float*)(ws + WS_CTL);
    bf16* X0b = (bf16*)(ws + WS_HB);
    for (int r = gw; r < T_ROWS; r += 4 * NGW) {
        v4f v[4][4];
#pragma unroll
        for (int u = 0; u < 4; ++u) { const int rr = (r + u * NGW) < T_ROWS ? r + u * NGW : r;
            const float* src = rr < NPROMPT ? a.in[0] + (size_t)rr * DM : (rr < NREAL ? a.in[1] + (size_t)(rr - NPROMPT) * DM : a.in[6] + (size_t)((rr - NREAL) & 15) * DM);
            const v4f* xr = (const v4f*)src + lane;
#pragma unroll
            for (int j = 0; j < 4; ++j) v[u][j] = __builtin_nontemporal_load(xr + 64 * j); }
#pragma unroll
        for (int u = 0; u < 4; ++u) { const int rr = r + u * NGW; if (rr < T_ROWS) {
            float sq = 0.f;
#pragma unroll
            for (int j = 0; j < 4; ++j) sq += (v[u][j].x * v[u][j].x + v[u][j].y * v[u][j].y) + (v[u][j].z * v[u][j].z + v[u][j].w * v[u][j].w);
            sq = wave_sum(sq);
            v2u* o8 = (v2u*)(X0b + (size_t)rr * DM) + lane;
#pragma unroll
            for (int j = 0; j < 4; ++j) { v2u w; w.x = pk2(v[u][j].x, v[u][j].y); w.y = pk2(v[u][j].z, v[u][j].w); o8[64 * j] = w; }
            if (lane == 0) ssq0[rr] = sq; } }
    }
    constexpr int NITEMS = 6 * (16 * 88) + 16 * 120 + 16 * 32;
    v4f ld[8];
    int cur = gw;
    TrItem tc; if (cur < NITEMS) { tc = tr_decode(a, ws, cur); tr_load(tc, lane, ld); }
    while (cur < NITEMS) {
        tr_to_lds(tc, lane, ld, scr);
        const int nxt = cur + NGW; TrItem tn = tc;
        if (nxt < NITEMS) { tn = tr_decode(a, ws, nxt); tr_load(tn, lane, ld); }
        LDS_WAIT(); asm volatile("" ::: "memory");
        tr_store(tc, lane, scr);
        LDS_WAIT(); asm volatile("" ::: "memory");
        tc = tn; cur = nxt;
    }
}

__device__ __forceinline__ float prevval(const bf16* PROJ, const float* sshift, int r, int col) {
    if (r < NPROMPT) { const int s = r & 2047; const int pr = s ? r - 1 : NREAL + (r >> 11) * 16 + 15; return bf2f(PROJ[(size_t)pr * NINP + col]); }
    if (r < NREAL) return sshift[(size_t)(r - NPROMPT) * NA_IN + col];
    return ((r - NREAL) & 15) ? bf2f(PROJ[(size_t)(r - 1) * NINP + col]) : 0.f;
}
__device__ __forceinline__ float tapval(const bf16* PROJ, const float* sconv, int r, int jb, int col) {
    if (r >= NPROMPT && r < NREAL) return sconv[((size_t)(r - NPROMPT) * 3 + (3 - jb)) * 1536 + col];
    int b, pos; if (r < NPROMPT) { b = r >> 11; pos = 16 + (r & 2047); } else { b = (r - NREAL) >> 4; pos = (r - NREAL) & 15; }
    const int pp = pos - jb; if (pp < 0) return 0.f;
    return bf2f(PROJ[(size_t)seqrow(b, pp) * NINP + NB_OFF + col]);
}
struct RowIdx { int t1, t2, t3; float m1, m2, m3; bool samp; };
__device__ __forceinline__ RowIdx rowidx(int r) {
    RowIdx x; int b, pos; x.samp = (r >= NPROMPT) && (r < NREAL);
    if (r < NPROMPT) { b = r >> 11; pos = 16 + (r & 2047); } else if (r >= NREAL) { b = (r - NREAL) >> 4; pos = (r - NREAL) & 15; } else { b = 0; pos = 64; }
    x.t1 = seqrow(b, pos >= 1 ? pos - 1 : 0); x.t2 = seqrow(b, pos >= 2 ? pos - 2 : 0); x.t3 = seqrow(b, pos >= 3 ? pos - 3 : 0);
    x.m1 = pos >= 1 ? 1.f : 0.f; x.m2 = pos >= 2 ? 1.f : 0.f; x.m3 = pos >= 3 ? 1.f : 0.f; return x;
}
__device__ __forceinline__ void p4_prep(const Ctx& a, LAS unsigned char* lds) {
    const int c = fresh_tid(), lane = c & 63, wave = c >> 6;
    unsigned char* ws = a.ws;
    const bf16* PROJ = (const bf16*)(ws + WS_BIG);
    bf16* AD = (bf16*)(ws + WS_WB); bf16* AK = (bf16*)(ws + WS_HB); bf16* AKK = (bf16*)(ws + WS_HB + SZ_ARR); bf16* AKA = (bf16*)(ws + WS_X3);
    bf16* GQ = (bf16*)(ws + WS_X4); bf16* GK = (bf16*)(ws + WS_X5);
    float* GB = (float*)(ws + OFF_GB); float* GE = (float*)(ws + OFF_GE); float* BONUS = (float*)(ws + OFF_BONUS);
    const float* mu = a.in[13]; const float* sshift = a.in[3]; const float* sconv = a.in[5];
    const float mu_r = mu[c], mu_k = mu[512 + c];
    const float w0 = a.in[14][c], a0 = a.in[16][c], kkw = a.in[19][c], kaw = a.in[20][c], rkw = a.in[21][c];
    float wdu[32], wau[32];
#pragma unroll
    for (int j = 0; j < 32; ++j) { wdu[j] = a.in[15][j * 512 + c]; wau[j] = a.in[17][j * 512 + c]; }
    float cq[4], ck[4];
#pragma unroll
    for (int j = 0; j < 4; ++j) { cq[j] = a.in[24][j * 1536 + c]; ck[j] = a.in[24][j * 1536 + 512 + c]; }
    const float mu_x = mu[1536 + (c & 63)];
    const float alog = a.in[25][c & 3], dtb = a.in[26][c & 3];
    LAS float* L = (LAS float*)lds;
    constexpr int RI = 5;
    const int r0 = blockIdx.x * 65;
    for (int it = 0; it < 14; ++it) {
        const bool slow = (it == 13);
        if (slow && blockIdx.x >= 128) break;
        LAS float* Lq = L + (it & 1) * (RI * 96);
        float qv[RI], kv[RI], rr_[RI], kx_[RI], ar_[RI], br_[RI];
        bool st_ok[RI];
#pragma unroll
        for (int j = 0; j < RI; ++j) {
            if (slow && j > 0) break;
            const int r = slow ? NPROMPT + (int)blockIdx.x : r0 + it * RI + j; LAS float* Lp = Lq + j * 96;
            const bf16* pr = PROJ + (size_t)r * NINP;
            float q3, q2, q1, q0, k3, k2, k1, k0, rc, rp, kc_, kp_, xc, xp_;
            q3 = bf2f(pr[NB_OFF + c]); k3 = bf2f(pr[NB_OFF + 512 + c]); rc = bf2f(pr[c]); kc_ = bf2f(pr[512 + c]); xc = bf2f(pr[1536 + (c & 63)]);
            ar_[j] = bf2f(pr[NB_OFF + 2048 + (c & 3)]); br_[j] = bf2f(pr[NB_OFF + 2052 + (c & 3)]);
            if (!slow) {
                const RowIdx X = rowidx(r); st_ok[j] = !X.samp;
                const bf16* p1 = PROJ + (size_t)X.t1 * NINP; const bf16* p2 = PROJ + (size_t)X.t2 * NINP; const bf16* p3 = PROJ + (size_t)X.t3 * NINP;
                q2 = bf2f(p1[NB_OFF + c]) * X.m1; q1 = bf2f(p2[NB_OFF + c]) * X.m2; q0 = bf2f(p3[NB_OFF + c]) * X.m3;
                k2 = bf2f(p1[NB_OFF + 512 + c]) * X.m1; k1 = bf2f(p2[NB_OFF + 512 + c]) * X.m2; k0 = bf2f(p3[NB_OFF + 512 + c]) * X.m3;
                rp = bf2f(p1[c]) * X.m1; kp_ = bf2f(p1[512 + c]) * X.m1; xp_ = bf2f(p1[1536 + (c & 63)]) * X.m1;
            } else {
                st_ok[j] = true; const int i = r - NPROMPT;
                q2 = sconv[((size_t)i * 3 + 2) * 1536 + c]; q1 = sconv[((size_t)i * 3 + 1) * 1536 + c]; q0 = sconv[((size_t)i * 3 + 0) * 1536 + c];
                k2 = sconv[((size_t)i * 3 + 2) * 1536 + 512 + c]; k1 = sconv[((size_t)i * 3 + 1) * 1536 + 512 + c]; k0 = sconv[((size_t)i * 3 + 0) * 1536 + 512 + c];
                rp = sshift[(size_t)i * NA_IN + c]; kp_ = sshift[(size_t)i * NA_IN + 512 + c]; xp_ = sshift[(size_t)i * NA_IN + 1536 + (c & 63)];
            }
            const float qc = (q3 * cq[3] + q2 * cq[2]) + (q1 * cq[1] + q0 * cq[0]), kc = (k3 * ck[3] + k2 * ck[2]) + (k1 * ck[1] + k0 * ck[0]);
            const float q = pg8::silu_f(qc), k = pg8::silu_f(kc); qv[j] = q; kv[j] = k;
            rr_[j] = rc + (rp - rc) * mu_r; kx_[j] = kc_ + (kp_ - kc_) * mu_k;
            const float sq = wave_sum(q * q), sk = wave_sum(k * k);
            if (lane == 0) { Lp[64 + wave] = sq; Lp[72 + wave] = sk; }
            const float xm = xc + (xp_ - xc) * mu_x;
            if (c < 64) Lp[c] = (c < 32) ? tanh_f(xm) : xm;
        }
        __syncthreads();
#pragma unroll
        for (int j = 0; j < RI; ++j) {
            if (slow && j > 0) break;
            const int r = slow ? NPROMPT + (int)blockIdx.x : r0 + it * RI + j; LAS float* Lp = Lq + j * 96;
            const float q = qv[j], k = kv[j];
            const float tq = Lp[64 + wave] + Lp[64 + (wave ^ 1)], tk = Lp[72 + wave] + Lp[72 + (wave ^ 1)];
            float wl = w0, al = a0;
#pragma unroll
            for (int j4 = 0; j4 < 8; ++j4) { const v4f x = *(LAS v4f*)(Lp + 4 * j4), y = *(LAS v4f*)(Lp + 32 + 4 * j4);
#pragma unroll
                for (int i = 0; i < 4; ++i) { wl += x[i] * wdu[4 * j4 + i]; al += y[i] * wau[4 * j4 + i]; } }
            const float wlog = -softplus_f(-wl) - 0.5f; const float e = exp_f(wlog); const float dd = 1.0f - exp_f(-e);
            const float av = sigmoid_f(al);
            const float rr = rr_[j], kx = kx_[j];
            const float kkr = kx * kkw; const float ss = wave_sum(kkr * kkr); const float kkn = kkr * __builtin_amdgcn_rsqf(ss + 1e-12f);
            const float kp = kx * (1.0f + (av - 1.0f) * kaw);
            const float bs = wave_sum(rr * kp * rkw);
            if (st_ok[j]) {
                __builtin_nontemporal_store(f2bf(q * __builtin_amdgcn_rsqf(tq + 1e-12f) * 0.08838834764831845f), GQ + (size_t)r * 512 + c);
                __builtin_nontemporal_store(f2bf(k * __builtin_amdgcn_rsqf(tk + 1e-12f)), GK + (size_t)r * 512 + c);
                if (c < 4) { GB[r * 4 + c] = sigmoid_f(br_[j]); GE[r * 4 + c] = exp_f(-exp_f(alog) * softplus_f(ar_[j] + dtb)); }
                __builtin_nontemporal_store(f2bf(dd), AD + (size_t)r * 512 + c); __builtin_nontemporal_store(f2bf(kp), AK + (size_t)r * 512 + c); __builtin_nontemporal_store(f2bf(kkn), AKK + (size_t)r * 512 + c); __builtin_nontemporal_store(f2bf(kkn * av), AKA + (size_t)r * 512 + c);
                if (lane == 0) BONUS[r * 8 + wave] = bs;
            }
        }
    }
    float* out = a.out;
    const int gt = blockIdx.x * NTHREADS + c, NGT = gridDim.x * NTHREADS;
    for (int i = gt; i < 8 * 1696; i += NGT) { const int b = i / 1696, col = i % 1696; out[O_SHIFT_P + i] = bf2f(PROJ[(size_t)(b * 2048 + 2047) * NINP + col]); }
    for (int i = gt; i < 128 * 1696; i += NGT) { const int b = i / 1696, col = i % 1696; out[O_SHIFT_S + i] = bf2f(PROJ[(size_t)(NPROMPT + b) * NINP + col]); }
    for (int i = gt; i < 8 * 3 * 1536; i += NGT) { const int b = i / 4608, j = (i / 1536) % 3, col = i % 1536; out[O_CONV_P + i] = bf2f(PROJ[(size_t)(b * 2048 + 2045 + j) * NINP + NB_OFF + col]); }
    for (int i = gt; i < 128 * 3 * 1536; i += NGT) { const int b = i / 4608, j = (i / 1536) % 3, col = i % 1536;
        out[O_CONV_S + i] = (j < 2) ? sconv[((size_t)b * 3 + j + 1) * 1536 + col] : bf2f(PROJ[(size_t)(NPROMPT + b) * NINP + NB_OFF + col]); }
}

__device__ __forceinline__ void p6_scan(const Ctx& a, LAS unsigned char* lds) {
    const int tid = fresh_tid(), t2 = tid & 255, half = tid >> 8, tok = t2 >> 4, sub = t2 & 15;
    unsigned char* ws = a.ws;
    bf16* PROJ = (bf16*)(ws + WS_BIG);
    const bf16* AD = (const bf16*)(ws + WS_WB); const bf16* AK = (const bf16*)(ws + WS_HB); const bf16* AKK = (const bf16*)(ws + WS_HB + SZ_ARR); const bf16* AKA = (const bf16*)(ws + WS_X3);
    const bf16* GQ = (const bf16*)(ws + WS_X4); const bf16* GK = (const bf16*)(ws + WS_X5);
    const float* GB = (const float*)(ws + OFF_GB); const float* GE = (const float*)(ws + OFF_GE);
    const float* mu = a.in[13];
    float* out = a.out;
    LAS float* L = (LAS float*)lds;
    constexpr int BUF = 9792, OUTO = 2 * BUF;
    for (int unit = blockIdx.x; unit < 256; unit += gridDim.x) {
        int b, h, xb; if (half == 0) { b = unit >> 5; h = (unit >> 2) & 7; xb = unit & 3; } else { b = unit >> 5; h = (unit >> 3) & 3; xb = unit & 7; }
        v4f mu4 = {0.f, 0.f, 0.f, 0.f}; float muv = 0.f; float cw[4] = {0.f, 0.f, 0.f, 0.f};
        int ocol, vcol;
        if (half == 0) { mu4 = *(const v4f*)(mu + h * 64 + 4 * sub); vcol = 1024 + h * 64 + 16 * xb + sub; muv = mu[vcol]; ocol = 512 + h * 64 + 16 * xb + sub; }
        else { vcol = NB_OFF + 1024 + h * 128 + 16 * xb + sub; ocol = NB_OFF + h * 128 + 16 * xb + sub;
#pragma unroll
            for (int j = 0; j < 4; ++j) cw[j] = a.in[24][j * 1536 + 1024 + h * 128 + 16 * xb + sub]; }
        v2f s0 = {0.f, 0.f}, s1 = {0.f, 0.f}, s2 = {0.f, 0.f}, s3 = {0.f, 0.f};
        v2u s_rc, s_rp, s_d, s_k, s_kk, s_ka; v4u s_q, s_gk; unsigned short s_v0 = 0, s_v1 = 0, s_v2 = 0, s_v3 = 0; float s_b = 0.f, s_e = 0.f;
        s_rc = s_rp = s_d = s_k = s_kk = s_ka = (v2u){0u, 0u}; s_q = s_gk = (v4u){0u, 0u, 0u, 0u};
#define P6_LOAD(n) do { const int _n = (n); const int row = (_n == 0) ? NREAL + b * 16 + tok : b * 2048 + (_n - 1) * 16 + tok; \
            if (half == 0) { const int ch = h * 64 + 4 * sub; const int prow = (tok > 0 || _n > 1) ? row - 1 : (_n == 1 ? NREAL + b * 16 + 15 : -1); \
                s_rc = *(const v2u*)(PROJ + (size_t)row * NINP + ch); s_rp = prow >= 0 ? *(const v2u*)(PROJ + (size_t)prow * NINP + ch) : (v2u){0u, 0u}; \
                s_d = *(const v2u*)(AD + (size_t)row * 512 + ch); s_k = *(const v2u*)(AK + (size_t)row * 512 + ch); s_kk = *(const v2u*)(AKK + (size_t)row * 512 + ch); s_ka = *(const v2u*)(AKA + (size_t)row * 512 + ch); \
                s_v0 = PROJ[(size_t)row * NINP + vcol]; s_v1 = prow >= 0 ? PROJ[(size_t)prow * NINP + vcol] : (unsigned short)0; } \
            else { const int ch = h * 128 + 8 * sub; s_q = *(const v4u*)(GQ + (size_t)row * 512 + ch); s_gk = *(const v4u*)(GK + (size_t)row * 512 + ch); \
                const int pos = _n * 16 + tok; s_v0 = PROJ[(size_t)row * NINP + vcol]; \
                s_v1 = pos >= 1 ? PROJ[(size_t)seqrow(b, pos - 1) * NINP + vcol] : (unsigned short)0; s_v2 = pos >= 2 ? PROJ[(size_t)seqrow(b, pos - 2) * NINP + vcol] : (unsigned short)0; \
                s_v3 = pos >= 3 ? PROJ[(size_t)seqrow(b, pos - 3) * NINP + vcol] : (unsigned short)0; \
                if (sub == 0) { s_b = GB[row * 4 + h]; s_e = GE[row * 4 + h]; } } } while (0)
#define P6_WRITE(bufi) do { LAS float* Lb = L + (bufi) * BUF; \
            if (half == 0) { const int o = tok * 64 + 4 * sub; \
                v4f c4 = {bflo(s_rc.x), bfhi(s_rc.x), bflo(s_rc.y), bfhi(s_rc.y)}, p4 = {bflo(s_rp.x), bfhi(s_rp.x), bflo(s_rp.y), bfhi(s_rp.y)}; \
                *(LAS v4f*)(Lb + o) = c4 + (p4 - c4) * mu4; \
                *(LAS v4f*)(Lb + 1024 + o) = (v4f){bflo(s_d.x), bfhi(s_d.x), bflo(s_d.y), bfhi(s_d.y)}; \
                *(LAS v4f*)(Lb + 2048 + o) = (v4f){bflo(s_k.x), bfhi(s_k.x), bflo(s_k.y), bfhi(s_k.y)}; \
                *(LAS v4f*)(Lb + 3072 + o) = (v4f){bflo(s_kk.x), bfhi(s_kk.x), bflo(s_kk.y), bfhi(s_kk.y)}; \
                *(LAS v4f*)(Lb + 4096 + o) = (v4f){bflo(s_ka.x), bfhi(s_ka.x), bflo(s_ka.y), bfhi(s_ka.y)}; \
                const float vc_ = bf2f(s_v0); Lb[5120 + tok * 16 + sub] = vc_ + (bf2f(s_v1) - vc_) * muv; } \
            else { const int o = tok * 128 + 4 * sub;   \
                *(LAS v4f*)(Lb + 5376 + o) = (v4f){bflo(s_q.x), bfhi(s_q.x), bflo(s_q.y), bfhi(s_q.y)}; *(LAS v4f*)(Lb + 5376 + o + 64) = (v4f){bflo(s_q.z), bfhi(s_q.z), bflo(s_q.w), bfhi(s_q.w)}; \
                *(LAS v4f*)(Lb + 7424 + o) = (v4f){bflo(s_gk.x), bfhi(s_gk.x), bflo(s_gk.y), bfhi(s_gk.y)}; *(LAS v4f*)(Lb + 7424 + o + 64) = (v4f){bflo(s_gk.z), bfhi(s_gk.z), bflo(s_gk.w), bfhi(s_gk.w)}; \
                const float cv = bf2f(s_v0) * cw[3] + bf2f(s_v1) * cw[2] + bf2f(s_v2) * cw[1] + bf2f(s_v3) * cw[0]; Lb[9472 + tok * 16 + sub] = pg8::silu_f(cv); \
                if (sub == 0) { Lb[9728 + tok] = s_b; Lb[9744 + tok] = s_e; } } } while (0)
        P6_LOAD(0); P6_WRITE(0);
        __syncthreads();
        for (int n = 0; n < 129; ++n) {
            if (n + 1 < 129) P6_LOAD(n + 1);
            const LAS float* Lb = L + (n & 1) * BUF; LAS float* Lo = L + OUTO + (n & 1) * 512 + half * 256;
            float op[16];
            if (half == 0) {
#pragma unroll
                for (int s = 0; s < 16; ++s) {
                    const LAS float* p = Lb + s * 64 + 4 * sub;
                    const v4f r4 = *(const LAS v4f*)p, d4 = *(const LAS v4f*)(p + 1024), k4 = *(const LAS v4f*)(p + 2048), kk4 = *(const LAS v4f*)(p + 3072), ka4 = *(const LAS v4f*)(p + 4096);
                    const float v = Lb[5120 + s * 16 + tok];
                    v2f t = s0 * kk4.lo; t = fma2(s1, kk4.hi, t);
                    const float sa = red16(t.x + t.y);
                    const v2f vv = {v, v};
                    v2f y0 = fma2(s0, -d4.lo, s0), y1 = fma2(s1, -d4.hi, s1);
                    y0 = fma2(vv, k4.lo, y0); y1 = fma2(vv, k4.hi, y1);
                    const v2f ns = {-sa, -sa};
                    s0 = fma2(ns, ka4.lo, y0); s1 = fma2(ns, ka4.hi, y1);
                    v2f u = s0 * r4.lo; u = fma2(s1, r4.hi, u);
                    op[s] = u.x + u.y;
                }
            } else {
#pragma unroll
                for (int s = 0; s < 16; ++s) {
                    const LAS float* pq = Lb + 5376 + s * 128 + 4 * sub;
                    const v4f q0 = *(const LAS v4f*)pq, q1 = *(const LAS v4f*)(pq + 64), k0 = *(const LAS v4f*)(pq + 2048), k1 = *(const LAS v4f*)(pq + 2048 + 64);
                    const float v = Lb[9472 + s * 16 + tok], be = Lb[9728 + s], eg = Lb[9744 + s];
                    v2f t = s0 * k0.lo; t = fma2(s1, k0.hi, t); v2f u = s2 * k1.lo; u = fma2(s3, k1.hi, u); t += u;
                    const float p = red16(t.x + t.y);
                    const v2f eg2 = {eg, eg};
                    const v2f e0 = s0 * eg2, e1 = s1 * eg2, e2 = s2 * eg2, e3 = s3 * eg2;
                    const float vn = be * (v - eg * p); const v2f vn2 = {vn, vn};
                    s0 = fma2(k0.lo, vn2, e0); s1 = fma2(k0.hi, vn2, e1); s2 = fma2(k1.lo, vn2, e2); s3 = fma2(k1.hi, vn2, e3);
                    v2f w = s0 * q0.lo; w = fma2(s1, q0.hi, w); v2f z = s2 * q1.lo; z = fma2(s3, q1.hi, z); w += z;
                    op[s] = w.x + w.y;
                }
            }
            { int jj; const float tot = treduce16(op, sub, jj); Lo[jj * 16 + tok] = tot; }
            if (n + 1 < 129) P6_WRITE((n + 1) & 1);
            __syncthreads();
            { const int row = (n == 0) ? NREAL + b * 16 + tok : b * 2048 + (n - 1) * 16 + tok; PROJ[(size_t)row * NINP + ocol] = f2bf(Lo[tok * 16 + sub]); }
        }
        if (half == 0) { *(v4f*)(out + O_RWKV_P + ((size_t)((b * 8 + h) * 64 + 16 * xb + tok)) * 64 + 4 * sub) = (v4f){s0.x, s0.y, s1.x, s1.y}; }
        else { const float fs[8] = {s0.x, s0.y, s1.x, s1.y, s2.x, s2.y, s3.x, s3.y};
#pragma unroll
            for (int i = 0; i < 8; ++i) out[O_GDN_P + ((size_t)((b * 4 + h) * 128 + 8 * sub + i)) * 128 + 16 * xb + tok] = fs[i]; }
        __syncthreads();
    }
#undef P6_LOAD
#undef P6_WRITE
    {
        const int g = tid >> 4;
        for (int w = blockIdx.x; w < 2048; w += gridDim.x) {
            const int i = w >> 4, h = (w >> 1) & 7, row = (w & 1) * 32 + g, rt = NPROMPT + i, ch = h * 64 + 4 * sub;
            const v2u rc = *(const v2u*)(PROJ + (size_t)rt * NINP + ch); const v4f rp = *(const v4f*)(a.in[3] + (size_t)i * NA_IN + ch); const v4f m4 = *(const v4f*)(mu + ch);
            const v4f c4 = {bflo(rc.x), bfhi(rc.x), bflo(rc.y), bfhi(rc.y)}; const v4f r4 = c4 + (rp - c4) * m4;
            const v2u ud = *(const v2u*)(AD + (size_t)rt * 512 + ch), uk = *(const v2u*)(AK + (size_t)rt * 512 + ch), ukk = *(const v2u*)(AKK + (size_t)rt * 512 + ch), uka = *(const v2u*)(AKA + (size_t)rt * 512 + ch);
            const v4f d4 = {bflo(ud.x), bfhi(ud.x), bflo(ud.y), bfhi(ud.y)}, k4 = {bflo(uk.x), bfhi(uk.x), bflo(uk.y), bfhi(uk.y)};
            const v4f kk4 = {bflo(ukk.x), bfhi(ukk.x), bflo(ukk.y), bfhi(ukk.y)}, ka4 = {bflo(uka.x), bfhi(uka.x), bflo(uka.y), bfhi(uka.y)};
            const int vc = 1024 + h * 64 + row; const float vcur = bf2f(PROJ[(size_t)rt * NINP + vc]); const float v = vcur + (a.in[3][(size_t)i * NA_IN + vc] - vcur) * mu[vc];
            const size_t so = ((size_t)((i * 8 + h) * 64 + row)) * 64 + 4 * sub;
            v4f s4 = __builtin_nontemporal_load((const v4f*)(a.in[2] + so));
            float sa = (s4[0] * kk4[0] + s4[1] * kk4[1]) + (s4[2] * kk4[2] + s4[3] * kk4[3]); sa = red16(sa);
#pragma unroll
            for (int j = 0; j < 4; ++j) { float x = fmaf(-d4[j], s4[j], s4[j]); x = fmaf(-sa, ka4[j], x); s4[j] = fmaf(v, k4[j], x); }
            float o = (s4[0] * r4[0] + s4[1] * r4[1]) + (s4[2] * r4[2] + s4[3] * r4[3]); o = red16(o);
            __builtin_nontemporal_store(s4, (v4f*)(out + O_RWKV_S + so));
            if (sub == 0) PROJ[(size_t)rt * NINP + 512 + h * 64 + row] = f2bf(o);
        }
    }
    {
        const int e = tid & 127, kq = tid >> 7;
        for (int w = blockIdx.x; w < 512; w += gridDim.x) {
            const int i = w >> 2, h = w & 3, rt = NPROMPT + i;
            __syncthreads();
            if (tid < 128) L[tid] = bf2f(GK[(size_t)rt * 512 + h * 128 + tid]); else if (tid < 256) L[tid] = bf2f(GQ[(size_t)rt * 512 + h * 128 + tid - 128]);
            const int vcq = 1024 + h * 128 + e;
            float cv = bf2f(PROJ[(size_t)rt * NINP + NB_OFF + vcq]) * a.in[24][3 * 1536 + vcq];
#pragma unroll
            for (int j = 0; j < 3; ++j) cv += a.in[5][((size_t)i * 3 + j) * 1536 + vcq] * a.in[24][j * 1536 + vcq];
            const float v = pg8::silu_f(cv), be = GB[rt * 4 + h], eg = GE[rt * 4 + h];
            const size_t so = ((size_t)((i * 4 + h) * 128 + kq * 32)) * 128 + e;
            float S[32];
#pragma unroll
            for (int j = 0; j < 32; ++j) S[j] = __builtin_nontemporal_load(a.in[4] + so + (size_t)j * 128);
            __syncthreads();
            float p = 0.f;
#pragma unroll
            for (int j = 0; j < 32; ++j) p += L[kq * 32 + j] * S[j];
            L[256 + kq * 128 + e] = p;
            __syncthreads();
            p = (L[256 + e] + L[384 + e]) + (L[512 + e] + L[640 + e]);
            const float vn = be * (v - eg * p);
            float o = 0.f;
#pragma unroll
            for (int j = 0; j < 32; ++j) { S[j] = fmaf(L[kq * 32 + j], vn, eg * S[j]); o += L[128 + kq * 32 + j] * S[j]; }
            L[768 + kq * 128 + e] = o;
#pragma unroll
            for (int j = 0; j < 32; ++j) __builtin_nontemporal_store(S[j], out + O_GDN_S + so + (size_t)j * 128);
            __syncthreads();
            if (kq == 0) PROJ[(size_t)rt * NINP + NB_OFF + h * 128 + e] = f2bf((L[768 + e] + L[896 + e]) + (L[1024 + e] + L[1152 + e]));
        }
    }
}

__device__ __forceinline__ void p7_post(const Ctx& a, LAS unsigned char* lds) {
    const int c = fresh_tid(), lane = c & 63, wave = c >> 6;
    unsigned char* ws = a.ws;
    const bf16* PROJ = (const bf16*)(ws + WS_BIG);
    bf16* MIX = (bf16*)(ws + WS_HB);
    const float* BONUS = (const float*)(ws + OFF_BONUS);
    const float* mu = a.in[13]; const float* sshift = a.in[3];
    const int cg_ = c < 96 ? c : 95;
    const float mu_v = mu[1024 + c], lw = a.in[22][c], lb = a.in[23][c], nw = a.in[27][c & 127];
    const float mu_g = mu[1600 + cg_];
    float wg[96];
#pragma unroll
    for (int j = 0; j < 96; ++j) wg[j] = a.in[18][j * 512 + c];
    LAS float* L = (LAS float*)lds;
    constexpr int RI = 5;
    const int r0 = blockIdx.x * 65;
    const int nrows = (NREAL - r0) < 65 ? ((NREAL - r0) < 0 ? 0 : NREAL - r0) : 65;
    const int nit = (nrows + RI - 1) / RI;
    for (int it = 0; it <= nit; ++it) {
        const bool slow = (it == nit);
        if (slow && blockIdx.x >= 128) break;
        LAS float* Lq = L + (it & 1) * (RI * 112);
        float ogv[RI], ov[RI], vv[RI], zv[RI], bv[RI]; bool st_ok[RI];
#pragma unroll
        for (int j = 0; j < RI; ++j) {
            if (slow && j > 0) break;
            int r = r0 + it * RI + j; r = r < r0 + nrows ? r : r0 + nrows - 1; if (slow) r = NPROMPT + (int)blockIdx.x;
            LAS float* Lp = Lq + j * 112;
            const bf16* pr = PROJ + (size_t)r * NINP;
            const float gc = bf2f(pr[1600 + cg_]), vc = bf2f(pr[1024 + c]);
            ogv[j] = bf2f(pr[NB_OFF + c]); ov[j] = bf2f(pr[512 + c]); zv[j] = bf2f(pr[NB_OFF + 1536 + c]); bv[j] = BONUS[r * 8 + wave];
            float gp, vp;
            if (!slow) { const RowIdx X = rowidx(r); st_ok[j] = !X.samp; const bf16* p1 = PROJ + (size_t)X.t1 * NINP; gp = bf2f(p1[1600 + cg_]) * X.m1; vp = bf2f(p1[1024 + c]) * X.m1; }
            else { st_ok[j] = true; const int i = r - NPROMPT; gp = sshift[(size_t)i * NA_IN + 1600 + cg_]; vp = sshift[(size_t)i * NA_IN + 1024 + c]; }
            vv[j] = vc + (vp - vc) * mu_v;
            const float sg = sigmoid_f(gc + (gp - gc) * mu_g);
            if (c < 96) Lp[c] = sg;
            const float s2 = wave_sum(ogv[j] * ogv[j]);
            if (lane == 0) Lp[96 + wave] = s2;
        }
        __syncthreads();
#pragma unroll
        for (int j = 0; j < RI; ++j) {
            if (slow && j > 0) break;
            int r = r0 + it * RI + j; r = r < r0 + nrows ? r : r0 + nrows - 1; if (slow) r = NPROMPT + (int)blockIdx.x;
            LAS float* Lp = Lq + j * 112;
            const float o = ov[j];
            const float mean = wave_sum(o) * (1.0f / 64.0f); const float dlt = o - mean; const float var = wave_sum(dlt * dlt) * (1.0f / 64.0f);
            const float on = dlt * __builtin_amdgcn_rsqf(var + 64e-5f) * lw + lb;
            float g = 0.f;
#pragma unroll
            for (int j4 = 0; j4 < 24; ++j4) { const v4f x = *(LAS v4f*)(Lp + 4 * j4);
#pragma unroll
                for (int i = 0; i < 4; ++i) g += x[i] * wg[4 * j4 + i]; }
            const float ms = (Lp[96 + wave] + Lp[96 + (wave ^ 1)]) * (1.0f / 128.0f);
            if (st_ok[j]) {
                MIX[(size_t)r * DM + c] = f2bf((on + bv[j] * vv[j]) * g);
                MIX[(size_t)r * DM + 512 + c] = f2bf(ogv[j] * __builtin_amdgcn_rsqf(ms + 1e-6f) * nw * pg8::silu_f(zv[j]));
            }
        }
    }
}

__device__ __forceinline__ void p12_final(const Ctx& a) {
    const int tid = fresh_tid(), lane = tid & 63, wave = tid >> 6;
    const int gw = blockIdx.x * 8 + wave, NGW = gridDim.x * 8;
    const float* ssq3 = (const float*)(a.ws + WS_CTL) + 3 * 16640;
    const v4f* gf = (const v4f*)a.in[33] + lane;
    v4f g[4];
#pragma unroll
    for (int j = 0; j < 4; ++j) g[j] = gf[64 * j];
    for (int r = gw; r < NREAL; r += NGW) {
        const float rs = __builtin_amdgcn_rsqf(ssq3[r] * (1.0f / 1024.0f) + 1e-6f);
        v4f* p = (v4f*)(a.out + (size_t)r * DM) + lane;
#pragma unroll
        for (int j = 0; j < 4; ++j) p[64 * j] = p[64 * j] * rs * g[j];
    }
}


template <int MODE> __device__ __forceinline__ void gemm_tail(LAS unsigned char* lds, const bf16* A, const bf16* Bt, int K, float* H, bf16* Hb, float* ssq, const float* xs, const float* meta, const bf16* Hin16 = nullptr, const float* gfin = nullptr, unsigned* cnt = nullptr) {
    const int tid = fresh_tid(), lane = tid & 63, wave = tid >> 6, fr = lane & 15, fq = lane >> 4;
    const int kh = wave >> 2;
    const int nrt = (MODE == 0) ? 16 : 8;
    const float SC = (MODE == 1) ? 1.0f : 0.5f;
    const int ksteps = K / 64;
    LAS v4f* X = (LAS v4f*)lds;
    for (int t = blockIdx.x * 4 + (wave & 3); t < nrt * 64; t += gridDim.x * 4) {
        const int m0 = NPROMPT + (t >> 6) * 16, n0 = (t & 63) * 16;
        const pg8::bf16x8* pa = (const pg8::bf16x8*)(A + (size_t)(m0 + fr) * K + 8 * fq) + 4 * ksteps * kh;
        const pg8::bf16x8* pb = (const pg8::bf16x8*)(Bt + (size_t)(n0 + fr) * K + 8 * fq) + 4 * ksteps * kh;
        v4f acc = {0.f, 0.f, 0.f, 0.f};
        const int row = m0 + fr, col = n0 + 4 * fq;
        v4f hv = {0.f, 0.f, 0.f, 0.f};
        if (kh == 0) { const v2u w = *(const v2u*)(Hin16 + (size_t)row * DM + col); hv = (v4f){bflo(w.x), bfhi(w.x), bflo(w.y), bfhi(w.y)}; }
#pragma unroll 8
        for (int k = 0; k < ksteps; ++k) acc = __builtin_amdgcn_mfma_f32_16x16x32_bf16(pb[4 * k], pa[4 * k], acc, 0, 0, 0);
        if (kh == 1) X[(wave & 3) * 64 + lane] = acc;
        __syncthreads();
        if (MODE == 2) {
            v4f o = {0.f, 0.f, 0.f, 0.f};
            if (kh == 0) { acc += X[(wave & 3) * 64 + lane]; o = hv + SC * acc;
                float sq = (o[0] * o[0] + o[1] * o[1]) + (o[2] * o[2] + o[3] * o[3]);
                sq += __shfl_xor(sq, 16); sq += __shfl_xor(sq, 32);
                if (fq == 0) unsafeAtomicAdd(ssq + row, sq); }
            asm volatile("s_waitcnt vmcnt(0)" ::: "memory"); __syncthreads();
            if (tid == 0) { unsigned* c = cnt + 64 * (64 + (int)((blockIdx.x * 4) >> 6)); __hip_atomic_fetch_add(c, 4u, __ATOMIC_RELAXED, __HIP_MEMORY_SCOPE_AGENT);
                unsigned sp = 0; while (__hip_atomic_load(c, __ATOMIC_RELAXED, __HIP_MEMORY_SCOPE_AGENT) < 64u) { __builtin_amdgcn_s_sleep(1); if (++sp > (1u << 22)) break; } }
            __syncthreads();
            if (kh == 0) { const float rs = __builtin_amdgcn_rsqf(__hip_atomic_load(ssq + row, __ATOMIC_RELAXED, __HIP_MEMORY_SCOPE_AGENT) * (1.0f / 1024.0f) + 1e-6f);
                *(v4f*)(H + (size_t)row * DM + col) = o * rs * *(const v4f*)(gfin + col); }
            continue;
        }
        if (kh == 0) {
            acc += X[(wave & 3) * 64 + lane];
            const v4f o = hv + SC * acc;
            if (MODE != 2) { v2u w; w.x = pk2(o[0], o[1]); w.y = pk2(o[2], o[3]); *(v2u*)(Hb + (size_t)row * DM + col) = w; }
            float sq = (o[0] * o[0] + o[1] * o[1]) + (o[2] * o[2] + o[3] * o[3]);
            sq += __shfl_xor(sq, 16); sq += __shfl_xor(sq, 32);
            if (fq == 0) unsafeAtomicAdd(ssq + row, sq);
        }
        __syncthreads();
    }
}

__global__ void __launch_bounds__(NTHREADS, 2) fwd_kernel(Args a) {
    extern __shared__ __attribute__((aligned(16))) unsigned char lds_raw[];
    LAS unsigned char* lds = (LAS unsigned char*)lds_raw;
    cg::grid_group grid = cg::this_grid();
    unsigned char* ws = a.ws;
    float* ssq = (float*)(ws + WS_CTL);
    const int G = gridDim.x, bx = blockIdx.x;
    if (threadIdx.x < 64) ((LAS unsigned*)(lds + 131072))[threadIdx.x] = 0u;
    __syncthreads();
    XcdBarrier xbar = xcd_barrier_post((unsigned*)(ws + OFF_BAR), (volatile LAS unsigned*)(lds + 131072));
#define GSYNC() xcd_barrier(xbar)

    p0_prologue(a, lds);
    if (a.ws == nullptr) grid.sync();
    GSYNC();
    const Ctx cx{(const float* const*)(ws + OFF_TAB), a.out, a.ws};
    {
        pg8::Gemm g{(const bf16*)(ws + WS_HB), (const bf16*)(ws + WS_WGU1), T_ROWS, 5632, 1024}; pg8::StaticOrder S; S.init(T_ROWS, 5632, G, bx);
        pg8::EpiSwiglu E{(bf16*)(ws + WS_BIG), ssq};
        pg8::gemm_phase<pg8::EpiSwiglu, pg8::StaticOrder, true, true>(lds, g, S, E);
    }
    GSYNC();
    {
        pg8::Gemm g{(const bf16*)(ws + WS_BIG), (const bf16*)(ws + WS_WD1), T_ROWS, 1024, 2816}; pg8::StaticOrder S; S.init(NPROMPT, 1024, G, bx);
        pg8::EpiResid<0> E{(const bf16*)(ws + WS_HB), (bf16*)a.out, ssq + 16640, nullptr, nullptr, nullptr};
        pg8::gemm_phase<pg8::EpiResid<0>, pg8::StaticOrder, true, true>(lds, g, S, E);
        gemm_tail<0>(lds, (const bf16*)(ws + WS_BIG), (const bf16*)(ws + WS_WD1), 2816, nullptr, (bf16*)a.out, ssq + 16640, nullptr, nullptr, (const bf16*)(ws + WS_HB));
    }
    GSYNC();
    {
        pg8::Gemm g{(const bf16*)a.out, (const bf16*)(ws + WS_WIN), T_ROWS, 3840, 1024}; pg8::StaticOrder S; S.init(T_ROWS, 3840, G, bx);
        pg8::EpiProj E{(bf16*)(ws + WS_BIG), ssq + 16640};
        pg8::gemm_phase<pg8::EpiProj, pg8::StaticOrder, true, true>(lds, g, S, E);
    }
    GSYNC();
    p4_prep(cx, lds);
    GSYNC();
    p6_scan(cx, lds);
    GSYNC();
    p7_post(cx, lds);
    GSYNC();
    {
        pg8::Gemm g{(const bf16*)(ws + WS_HB), (const bf16*)(ws + WS_WOUT), T_ROWS, 1024, 1024}; pg8::StaticOrder S; S.init(NPROMPT, 1024, G, bx);
        pg8::EpiResid<1> E{(const bf16*)a.out, (bf16*)(ws + WS_X3), ssq + 2 * 16640, nullptr, nullptr, nullptr};
        pg8::gemm_phase<pg8::EpiResid<1>, pg8::StaticOrder, true, true>(lds, g, S, E);
        gemm_tail<1>(lds, (const bf16*)(ws + WS_HB), (const bf16*)(ws + WS_WOUT), 1024, nullptr, (bf16*)(ws + WS_X3), ssq + 2 * 16640, nullptr, nullptr, (const bf16*)a.out);
    }
    GSYNC();
    {
        pg8::Gemm g{(const bf16*)(ws + WS_X3), (const bf16*)(ws + WS_WGU2), T_ROWS, 5632, 1024}; pg8::StaticOrder S; S.init(T_ROWS, 5632, G, bx);
        pg8::EpiSwiglu E{(bf16*)(ws + WS_BIG), ssq + 2 * 16640};
        pg8::gemm_phase<pg8::EpiSwiglu, pg8::StaticOrder, true, true>(lds, g, S, E);
    }
    GSYNC();
    {
        pg8::Gemm g{(const bf16*)(ws + WS_BIG), (const bf16*)(ws + WS_WD2), T_ROWS, 1024, 2816}; pg8::StaticOrder S; S.init(NPROMPT, 1024, G, bx);
        pg8::EpiFinal E{(const bf16*)(ws + WS_X3), a.out, ssq + 3 * 16640, cx.in[33], (unsigned*)(ws + OFF_CNT)};
        pg8::gemm_phase<pg8::EpiFinal, pg8::StaticOrder, false, true>(lds, g, S, E);
        gemm_tail<2>(lds, (const bf16*)(ws + WS_BIG), (const bf16*)(ws + WS_WD2), 2816, a.out, nullptr, ssq + 3 * 16640, nullptr, nullptr, (const bf16*)(ws + WS_X3), cx.in[33], (unsigned*)(ws + OFF_CNT));
    }
}

extern "C" void kernel_launch(void* const* d_in, const int* in_sizes, int n_in, void* d_out, int out_size, void* d_ws, size_t ws_size, hipStream_t stream) {
    static int grid = 0;
    if (grid == 0) {
        int dev = 0, cus = 0, per_cu = 0;
        hipGetDevice(&dev);
        hipDeviceGetAttribute(&cus, hipDeviceAttributeMultiprocessorCount, dev);
        hipFuncSetAttribute((const void*)fwd_kernel, hipFuncAttributeMaxDynamicSharedMemorySize, LDS_BYTES);
        hipOccupancyMaxActiveBlocksPerMultiprocessor(&per_cu, (const void*)fwd_kernel, NTHREADS, LDS_BYTES);
        if (per_cu < 1) per_cu = 1;
        grid = cus >= 256 ? 256 : cus;
        if (n_in != 34 || ws_size < WS_END || out_size != (int)O_END) { fprintf(stderr, "kernel_launch: unexpected sizes n_in %d ws %zu out %d\n", n_in, ws_size, out_size); }
    }
    hipMemsetAsync((char*)d_ws + WS_CTL, 0, CTL_ZERO, stream);
    Args a{};
    for (int i = 0; i < 34; ++i) a.in[i] = (const float*)d_in[i];
    a.out = (float*)d_out; a.ws = (unsigned char*)d_ws;
    void* args[] = {&a};
    hipError_t e = hipLaunchCooperativeKernel((const void*)fwd_kernel, dim3(grid), dim3(NTHREADS), args, LDS_BYTES, stream);
    if (e != hipSuccess) fprintf(stderr, "cooperative launch failed: %s (grid %d)\n", hipGetErrorString(e), grid);
}
```
